# Optimizing an MI355X kernel written in HIP

```python
import jax
import jax.numpy as jnp
from jax import lax
import numpy as np

D_MODEL = 1024
BATCH = 2
SEQ = 8192
DEPTH = 2
DEC_BATCH = 128
DEC_SEQ = 1
PAST_LEN = 8192
PAGE_SIZE = 128

N_EVEN = (DEPTH + 1) // 2
N_ODD = DEPTH // 2
A_HEADS = 8
A_KV_HEADS = 2
A_HEAD_DIM = 64
A_GROUP = A_HEADS // A_KV_HEADS
A_Q = A_HEADS * A_HEAD_DIM
A_KV = A_KV_HEADS * A_HEAD_DIM
WINDOW = 128
A_BLOCK = 128
B_HEADS = 4
B_KEY_DIM = 128
B_VAL_DIM = 128
B_FDIM = B_HEADS * B_KEY_DIM
B_WIDTH = B_HEADS * B_VAL_DIM
B_CHUNK = 64
EVEN_IN = A_Q + 2 * A_KV + 2 * B_FDIM + 2 * B_WIDTH
EVEN_OUT = A_Q + B_WIDTH
C_HEADS = 8
C_KEY_DIM = 128
C_VAL_DIM = 128
C_QK = C_HEADS * C_KEY_DIM
C_V = C_HEADS * C_VAL_DIM
C_CONV = 4
C_CONV_DIM = 2 * C_QK + C_V
C_CHUNK = 64
ODD_IN = C_CONV_DIM + C_V + 2 * C_HEADS
D_FF = 2816
N_MOD = 9
DN_ALPHA = (2 * DEPTH) ** 0.25
DN_BETA = (8 * DEPTH) ** -0.25
LN_EPS = 1e-5
NORM_EPS = 1e-6

kernel_name = 'hybrid_swa_hgrn2_gdn_step'


def layer_norm(x, g, b):
    xf = x.astype(jnp.float32)
    mu = jnp.mean(xf, axis=-1, keepdims=True)
    var = jnp.mean(jnp.square(xf - mu), axis=-1, keepdims=True)
    y = (xf - mu) * lax.rsqrt(var + LN_EPS)
    return (y * g.astype(jnp.float32) + b.astype(jnp.float32)).astype(x.dtype)


def rms_norm(x, g):
    xf = x.astype(jnp.float32)
    y = xf * lax.rsqrt(jnp.mean(jnp.square(xf), axis=-1, keepdims=True) + NORM_EPS)
    return y * g.astype(jnp.float32)


def l2_normalize(x):
    xf = x.astype(jnp.float32)
    return xf * lax.rsqrt(jnp.sum(jnp.square(xf), axis=-1, keepdims=True) + NORM_EPS)


def pad_time(t, n):
    return jnp.pad(t, [(0, 0), (0, n)] + [(0, 0)] * (t.ndim - 2))


def alibi_slopes():
    return jnp.asarray(2.0 ** (-8.0 * np.arange(1, A_HEADS + 1) / A_HEADS), dtype=jnp.float32)


def swiglu(h, w_up, w_down):
    gate, up = jnp.split(h @ w_up, 2, axis=-1)
    return (jax.nn.silu(gate) * up) @ w_down


def sink_window_attention(q, k, v, q_pos, k_pos, sinks):
    s = jnp.einsum('...qhgd,...khd->...hgqk', q, k).astype(jnp.float32) * (A_HEAD_DIM ** -0.5)
    dist = q_pos[..., :, None] - k_pos[..., None, :]
    valid = (dist >= 0) & (dist < WINDOW) & (k_pos[..., None, :] >= 0)
    dist = dist[..., None, None, :, :].astype(jnp.float32)
    valid = valid[..., None, None, :, :]
    slopes = alibi_slopes().reshape(A_KV_HEADS, A_GROUP, 1, 1)
    s = jnp.where(valid, s - slopes * dist, -jnp.inf)
    sink = sinks.astype(jnp.float32).reshape(A_KV_HEADS, A_GROUP, 1, 1)
    m = jnp.maximum(jnp.max(s, axis=-1, keepdims=True), sink)
    p = jnp.exp(s - m)
    p = p / (jnp.sum(p, axis=-1, keepdims=True) + jnp.exp(sink - m))
    return jnp.einsum('...hgqk,...khd->...qhgd', p.astype(v.dtype), v)


def swa_prompt(q, k, v, sinks):
    Bn, S_ = q.shape[:2]
    nb = S_ // A_BLOCK
    qb = q.reshape(Bn, nb, A_BLOCK, A_KV_HEADS, A_GROUP, A_HEAD_DIM)
    kp = jnp.pad(k, ((0, 0), (A_BLOCK, 0), (0, 0), (0, 0))).reshape(Bn, nb + 1, A_BLOCK, A_KV_HEADS, A_HEAD_DIM)
    vp = jnp.pad(v, ((0, 0), (A_BLOCK, 0), (0, 0), (0, 0))).reshape(Bn, nb + 1, A_BLOCK, A_KV_HEADS, A_HEAD_DIM)
    kb = jnp.concatenate([kp[:, :-1], kp[:, 1:]], axis=2)
    vb = jnp.concatenate([vp[:, :-1], vp[:, 1:]], axis=2)
    pos = jnp.arange(S_).reshape(nb, A_BLOCK)
    k_pos = jnp.concatenate([pos - A_BLOCK, pos], axis=1)
    o = sink_window_attention(qb, kb, vb, pos, k_pos, sinks)
    return o.reshape(Bn, S_, A_Q)


def hgrn2_scan(q, logf, k, v, S0):
    Bn, T, H, DK = q.shape
    DV = v.shape[-1]
    C = min(B_CHUNK, T)
    nc = -(-T // C)
    pad = nc * C - T
    q, logf, k, v = (pad_time(t, pad) for t in (q, logf, k, v))

    def blocks(t):
        return jnp.moveaxis(t.reshape((Bn, nc, C) + t.shape[2:]), 1, 0)

    causal = jnp.tril(jnp.ones((C, C), dtype=bool))[None, :, :, None, None]

    def step(S, xs):
        q_c, lf_c, k_c, v_c = xs
        A = jnp.cumsum(lf_c, axis=1)
        decay = jnp.exp(jnp.where(causal, A[:, :, None] - A[:, None, :], -jnp.inf))
        scores = jnp.einsum('bthk,bshk,btshk->bhts', q_c, k_c, decay)
        o = jnp.einsum('bhts,bshv->bthv', scores, v_c) + jnp.einsum('bthk,bhkv->bthv', q_c * jnp.exp(A), S)
        A_last = A[:, -1]
        S = jnp.exp(A_last)[..., None] * S + jnp.einsum('bshk,bshv->bhkv', k_c * jnp.exp(A_last[:, None] - A), v_c)
        return S, o

    S, o = lax.scan(step, S0, tuple(blocks(t) for t in (q, logf, k, v)))
    o = jnp.moveaxis(o, 0, 1).reshape(Bn, nc * C, H, DV)[:, :T]
    return o, S


def gated_delta_scan(q, k, v, log_alpha, beta, S0):
    Bn, T, H, DK = q.shape
    DV = v.shape[-1]
    C = min(C_CHUNK, T)
    nc = -(-T // C)
    pad = nc * C - T
    q, k, v, log_alpha, beta = (pad_time(t, pad) for t in (q, k, v, log_alpha, beta))

    def blocks(t):
        return jnp.moveaxis(t.reshape((Bn, nc, C, H) + t.shape[3:]), 3, 2)

    q, k, v, log_alpha, beta = (blocks(t) for t in (q, k, v, log_alpha, beta))
    G = jnp.cumsum(log_alpha, axis=-1)
    diff = G[..., :, None] - G[..., None, :]
    causal = jnp.tril(jnp.ones((C, C), dtype=bool))
    strict = jnp.tril(jnp.ones((C, C), dtype=bool), k=-1)
    decay_incl = jnp.exp(jnp.where(causal, diff, -jnp.inf))
    decay_strict = jnp.where(strict, decay_incl, 0.0)
    L = beta[..., :, None] * jnp.einsum('bnhtk,bnhsk->bnhts', k, k) * decay_strict
    M = L + jnp.eye(C, dtype=L.dtype)
    u = lax.linalg.triangular_solve(M, beta[..., None] * v, left_side=True, lower=True, unit_diagonal=True)
    w = lax.linalg.triangular_solve(M, (beta * jnp.exp(G))[..., None] * k, left_side=True, lower=True, unit_diagonal=True)
    qk = jnp.einsum('bnhtk,bnhsk->bnhts', q, k) * decay_incl
    q_dec = q * jnp.exp(G)[..., None]
    k_dec = k * jnp.exp(G[..., -1:] - G)[..., None]
    g_last = jnp.exp(G[..., -1])

    def step(S, xs):
        q_c, qk_c, u_c, w_c, k_c, gl_c = xs
        delta = u_c - jnp.einsum('bhtk,bhkv->bhtv', w_c, S)
        o = jnp.einsum('bhtk,bhkv->bhtv', q_c, S) + jnp.einsum('bhts,bhsv->bhtv', qk_c, delta)
        S = gl_c[..., None, None] * S + jnp.einsum('bhsk,bhsv->bhkv', k_c, delta)
        return S, o

    xs = tuple(jnp.moveaxis(t, 1, 0) for t in (q_dec, qk, u, w, k_dec, g_last))
    S, o = lax.scan(step, S0, xs)
    o = jnp.moveaxis(jnp.moveaxis(o, 0, 1), 2, 3).reshape(Bn, nc * C, H, DV)[:, :T]
    return o, S


def even_mixer(h, cache_k, cache_v, S0, w_in, w_out, sinks, norm_g, lower_bound):
    Bn, T, _ = h.shape
    splits = np.cumsum([A_Q, A_KV, A_KV, B_FDIM, B_FDIM, B_WIDTH]).tolist()
    q_a, k_a, v_a, q_b, f_b, i_b, g_b = jnp.split(h @ w_in, splits, axis=-1)
    q_a = q_a.reshape(Bn, T, A_KV_HEADS, A_GROUP, A_HEAD_DIM)
    k_a = k_a.reshape(Bn, T, A_KV_HEADS, A_HEAD_DIM)
    v_a = v_a.reshape(Bn, T, A_KV_HEADS, A_HEAD_DIM)
    if cache_k is None:
        o_a = swa_prompt(q_a, k_a, v_a, sinks)
        new_k, new_v = k_a[:, -WINDOW:], v_a[:, -WINDOW:]
    else:
        keys = jnp.concatenate([cache_k, k_a], axis=1)
        vals = jnp.concatenate([cache_v, v_a], axis=1)
        q_pos = PAST_LEN + jnp.arange(T)
        k_pos = PAST_LEN - WINDOW + jnp.arange(WINDOW + T)
        o_a = sink_window_attention(q_a, keys, vals, q_pos, k_pos, sinks).reshape(Bn, T, A_Q)
        new_k, new_v = keys[:, -WINDOW:], vals[:, -WINDOW:]
    qb = jax.nn.silu(q_b.astype(jnp.float32)).reshape(Bn, T, B_HEADS, B_KEY_DIM)
    lb = lower_bound.reshape(B_HEADS, B_KEY_DIM)
    f = lb + (1.0 - lb) * jax.nn.sigmoid(f_b.astype(jnp.float32).reshape(Bn, T, B_HEADS, B_KEY_DIM))
    vb = i_b.astype(jnp.float32).reshape(Bn, T, B_HEADS, B_VAL_DIM)
    o_b, S_new = hgrn2_scan(qb, jnp.log(f), 1.0 - f, vb, S0)
    o_b = rms_norm(o_b, norm_g) * jax.nn.silu(g_b.astype(jnp.float32).reshape(Bn, T, B_HEADS, B_VAL_DIM))
    o = jnp.concatenate([o_a, o_b.astype(h.dtype).reshape(Bn, T, B_WIDTH)], axis=-1)
    return o @ w_out, new_k, new_v, S_new


def odd_mixer(h, conv_hist, S0, w_in, w_out, conv_w, a_log, dt_bias, norm_g):
    Bn, T, _ = h.shape
    qkv, gate, a_in, b_in = jnp.split(h @ w_in, [C_CONV_DIM, C_CONV_DIM + C_V, C_CONV_DIM + C_V + C_HEADS], axis=-1)
    full = jnp.concatenate([conv_hist, qkv], axis=1)
    acc = full[:, 0:T] * conv_w[0]
    for j in range(1, C_CONV):
        acc = acc + full[:, j:j + T] * conv_w[j]
    qkv_c = jax.nn.silu(acc)
    new_hist = full[:, T:]
    q, k, v = jnp.split(qkv_c, [C_QK, 2 * C_QK], axis=-1)
    q = l2_normalize(q.reshape(Bn, T, C_HEADS, C_KEY_DIM)) * (C_KEY_DIM ** -0.5)
    k = l2_normalize(k.reshape(Bn, T, C_HEADS, C_KEY_DIM))
    v = v.astype(jnp.float32).reshape(Bn, T, C_HEADS, C_VAL_DIM)
    beta = jax.nn.sigmoid(b_in.astype(jnp.float32))
    log_alpha = -jnp.exp(a_log.astype(jnp.float32)) * jax.nn.softplus(a_in.astype(jnp.float32) + dt_bias.astype(jnp.float32))
    o, S_new = gated_delta_scan(q, k, v, log_alpha, beta, S0)
    o = rms_norm(o, norm_g) * jax.nn.silu(gate.astype(jnp.float32).reshape(Bn, T, C_HEADS, C_VAL_DIM))
    return o.astype(h.dtype).reshape(Bn, T, C_V) @ w_out, new_hist, S_new


def run_trunk(x, c, caches, p):
    Bn = x.shape[0]
    cs = jax.nn.silu(c)
    probs = jax.nn.softmax(p['hgrn_lb_logits'].astype(jnp.float32), axis=0)
    lower = jnp.cumsum(probs, axis=0)[1:] - probs[0]
    ks, vs, hs, gs, cvs = [], [], [], [], []
    for l in range(DEPTH):
        mods = (cs @ p['ada_w'][l] + p['ada_b'][l]).reshape(Bn, N_MOD, 1, D_MODEL)
        sh1, sc1, g1, sh2, sc2, g2, sh3, sc3, g3 = (mods[:, j] for j in range(N_MOD))
        ffn1 = swiglu(x * (1.0 + sc1) + sh1, p['ffn_w_up'][l, 0], p['ffn_w_down'][l, 0])
        x = layer_norm(DN_ALPHA * x + 0.5 * g1 * ffn1, p['ln_g'][l, 0], p['ln_b'][l, 0])
        hm = x * (1.0 + sc2) + sh2
        if l % 2 == 0:
            e = l // 2
            if caches is None:
                ck, cv = None, None
                S0 = jnp.zeros((Bn, B_HEADS, B_KEY_DIM, B_VAL_DIM), jnp.float32)
            else:
                ck, cv = caches[0][e], caches[1][e]
                S0 = caches[2][e].astype(jnp.float32)
            mix, nk, nv, nS = even_mixer(hm, ck, cv, S0, p['even_w_in'][e], p['even_w_out'][e], p['swa_sinks'][e], p['hgrn_norm_g'][e], lower[e])
            ks.append(nk)
            vs.append(nv)
            hs.append(nS)
        else:
            o_idx = l // 2
            if caches is None:
                hist = jnp.zeros((Bn, C_CONV - 1, C_CONV_DIM), x.dtype)
                S0 = jnp.zeros((Bn, C_HEADS, C_KEY_DIM, C_VAL_DIM), jnp.float32)
            else:
                hist = caches[4][o_idx]
                S0 = caches[3][o_idx].astype(jnp.float32)
            mix, nh, nS = odd_mixer(hm, hist, S0, p['odd_w_in'][o_idx], p['odd_w_out'][o_idx], p['gdn_conv_w'][o_idx], p['gdn_a_log'][o_idx], p['gdn_dt_bias'][o_idx], p['gdn_norm_g'][o_idx])
            gs.append(nS)
            cvs.append(nh)
        x = layer_norm(DN_ALPHA * x + g2 * mix, p['ln_g'][l, 1], p['ln_b'][l, 1])
        ffn2 = swiglu(x * (1.0 + sc3) + sh3, p['ffn_w_up'][l, 1], p['ffn_w_down'][l, 1])
        x = layer_norm(DN_ALPHA * x + 0.5 * g3 * ffn2, p['ln_g'][l, 2], p['ln_b'][l, 2])
    dt = x.dtype
    return x, jnp.stack(ks).astype(dt), jnp.stack(vs).astype(dt), jnp.stack(hs).astype(dt), jnp.stack(gs).astype(dt), jnp.stack(cvs).astype(dt)


def setup_inputs(seed: int = 0) -> dict:
    key = jax.random.key(seed)
    keys = iter(jax.random.split(key, 32))

    def nrm(shape, scale):
        return jax.random.normal(next(keys), shape, jnp.float32) * scale

    dt = jnp.exp(jax.random.uniform(next(keys), (N_ODD, C_HEADS), jnp.float32, minval=np.log(1e-3), maxval=np.log(1e-1)))
    return {
        'x_prompt': nrm((BATCH, SEQ, D_MODEL), 1.0),
        'x_sample': nrm((DEC_BATCH, DEC_SEQ, D_MODEL), 1.0),
        'cache_swa_k': nrm((N_EVEN, DEC_BATCH, WINDOW, A_KV_HEADS, A_HEAD_DIM), 1.0),
        'cache_swa_v': nrm((N_EVEN, DEC_BATCH, WINDOW, A_KV_HEADS, A_HEAD_DIM), 1.0),
        'state_hgrn': nrm((N_EVEN, DEC_BATCH, B_HEADS, B_KEY_DIM, B_VAL_DIM), 0.5),
        'state_gdn': nrm((N_ODD, DEC_BATCH, C_HEADS, C_KEY_DIM, C_VAL_DIM), 0.1),
        'state_gdn_conv': nrm((N_ODD, DEC_BATCH, C_CONV - 1, C_CONV_DIM), 1.0),
        'c_prompt': nrm((BATCH, D_MODEL), 1.0),
        'c_sample': nrm((DEC_BATCH, D_MODEL), 1.0),
        'ada_w': nrm((DEPTH, D_MODEL, N_MOD * D_MODEL), D_MODEL ** -0.5),
        'ada_b': nrm((DEPTH, N_MOD * D_MODEL), 0.01),
        'ln_g': 1.0 + nrm((DEPTH, 3, D_MODEL), 0.02),
        'ln_b': nrm((DEPTH, 3, D_MODEL), 0.02),
        'ffn_w_up': nrm((DEPTH, 2, D_MODEL, 2 * D_FF), D_MODEL ** -0.5),
        'ffn_w_down': nrm((DEPTH, 2, D_FF, D_MODEL), D_FF ** -0.5 * DN_BETA),
        'even_w_in': nrm((N_EVEN, D_MODEL, EVEN_IN), D_MODEL ** -0.5),
        'even_w_out': nrm((N_EVEN, EVEN_OUT, D_MODEL), EVEN_OUT ** -0.5 * DN_BETA),
        'swa_sinks': nrm((N_EVEN, A_HEADS), 1.0),
        'hgrn_norm_g': 1.0 + nrm((N_EVEN, B_VAL_DIM), 0.02),
        'hgrn_lb_logits': nrm((N_EVEN + 1, B_FDIM), 0.5),
        'odd_w_in': nrm((N_ODD, D_MODEL, ODD_IN), D_MODEL ** -0.5),
        'odd_w_out': nrm((N_ODD, C_V, D_MODEL), C_V ** -0.5 * DN_BETA),
        'gdn_conv_w': nrm((N_ODD, C_CONV, C_CONV_DIM), C_CONV ** -0.5),
        'gdn_a_log': jnp.log(jax.random.uniform(next(keys), (N_ODD, C_HEADS), jnp.float32, minval=1.0, maxval=16.0)),
        'gdn_dt_bias': dt + jnp.log(-jnp.expm1(-dt)),
        'gdn_norm_g': 1.0 + nrm((N_ODD, C_VAL_DIM), 0.02),
    }


def reference(x_prompt, x_sample, cache_swa_k, cache_swa_v, state_hgrn, state_gdn, state_gdn_conv, c_prompt, c_sample, ada_w, ada_b, ln_g, ln_b, ffn_w_up, ffn_w_down, even_w_in, even_w_out, swa_sinks, hgrn_norm_g, hgrn_lb_logits, odd_w_in, odd_w_out, gdn_conv_w, gdn_a_log, gdn_dt_bias, gdn_norm_g):
    p = dict(ada_w=ada_w, ada_b=ada_b, ln_g=ln_g, ln_b=ln_b, ffn_w_up=ffn_w_up, ffn_w_down=ffn_w_down, even_w_in=even_w_in, even_w_out=even_w_out, swa_sinks=swa_sinks, hgrn_norm_g=hgrn_norm_g, hgrn_lb_logits=hgrn_lb_logits, odd_w_in=odd_w_in, odd_w_out=odd_w_out, gdn_conv_w=gdn_conv_w, gdn_a_log=gdn_a_log, gdn_dt_bias=gdn_dt_bias, gdn_norm_g=gdn_norm_g)
    y_prompt, p_k, p_v, p_hgrn, p_gdn, p_conv = run_trunk(x_prompt, c_prompt, None, p)
    y_sample, s_k, s_v, s_hgrn, s_gdn, s_conv = run_trunk(x_sample, c_sample, (cache_swa_k, cache_swa_v, state_hgrn, state_gdn, state_gdn_conv), p)
    return (y_prompt, y_sample, p_k, p_v, p_hgrn, p_gdn, p_conv, s_k, s_v, s_hgrn, s_gdn, s_conv)
```

```cpp
#include <hip/hip_runtime.h>
#include <hip/hip_cooperative_groups.h>
#include <cstdio>
#include <cstdint>
namespace pg8 {
#define PG8_LAS __attribute__((address_space(3)))
typedef unsigned short bf16_t;
typedef short bf16x8 __attribute__((ext_vector_type(8)));
typedef float f32x4 __attribute__((ext_vector_type(4)));
typedef unsigned u32x4 __attribute__((ext_vector_type(4)));
constexpr int BM = 256, BK = 64, HALF = 128, HTB = HALF * BK * 2  , STAGE_BYTES = 8 * HTB, NXCD = 8, WGM = 8;

__host__ __device__ __forceinline__ int lds_byte(int r, int c) { const int st = (r >> 4) * 2 + (c >> 5), rr = r & 15, cc = c & 31, ob = rr * 64 + cc * 2; return st * 1024 + (ob ^ (((ob >> 9) & 1) << 5)); }
__host__ __device__ __forceinline__ void stage_rc(int b, int& R, int& C) { const int st = b / 1024, sb = b % 1024, swz = sb ^ (((sb >> 9) & 1) << 5); R = (st >> 1) * 16 + swz / 64; C = (st & 1) * 32 + (swz % 64) / 2; }
__host__ __device__ __forceinline__ int perm32(int rho) { const int n = rho >> 4, i = rho & 15; return 8 * (i >> 2) + 4 * n + (i & 3); }

struct Unit { int pm, pn; };
struct Gemm { const bf16_t* A; const bf16_t* Bt; int M, N, K; };

struct StaticOrder {
    int nM, nN, nwg, G, c;
    __host__ __device__ void init(int M, int N, int G_, int c_) { nM = M / BM; nN = N / BM; nwg = nM * nN; G = G_; c = c_; }
    __host__ __device__ bool next(int i, Unit& u) const {
        const long L = (long)i * G + c; if (L >= nwg) return false;
        int wgid = (int)L; { const int q = nwg / NXCD, r = nwg % NXCD, xcd = wgid % NXCD, off = wgid / NXCD; wgid = (xcd < r ? xcd * (q + 1) : r * (q + 1) + (xcd - r) * q) + off; }
        const int nig = WGM * nN, gid = wgid / nig, fm = gid * WGM, gsz = (nM - fm) < WGM ? (nM - fm) : WGM;
        u.pm = fm + ((wgid % nig) % gsz); u.pn = (wgid % nig) / gsz; return true;
    }
    __device__ __forceinline__ void a_ready(const Unit&) const {}
    __device__ __forceinline__ void done(const Unit&) const {}
};

__device__ __forceinline__ unsigned cvt_pk_bf16(float lo, float hi) { unsigned r; asm volatile("v_cvt_pk_bf16_f32 %0, %1, %2" : "=v"(r) : "v"(lo), "v"(hi)); return r; }
typedef float f32x2 __attribute__((ext_vector_type(2)));
template <class Epi, class Sched, bool ALIGN_EPI = false, bool SP2 = false>
__device__ __forceinline__ void gemm_phase(PG8_LAS unsigned char* lds, const Gemm g, const Sched& S, const Epi& E, const int tid) {
    const int wid = __builtin_amdgcn_readfirstlane(tid >> 6), lane = tid & 63, wr = wid >> 2, wc = wid & 3, fr = lane & 15, fq = lane >> 4;
    const int K = g.K, nt = K / BK;
    unsigned voffA[2], voffB[2];
#pragma unroll
    for (int i = 0; i < 2; ++i) { int R, C; stage_rc(tid * 16 + i * 8192, R, C); const int Rb = Epi::PERM ? ((R & ~31) + perm32(R & 31)) : R;
        voffA[i] = (unsigned)(R * K + C) * 2u; voffB[i] = (unsigned)(Rb * K + C) * 2u; }
    const size_t kstep = (size_t)(BK * 2);
    const size_t hstep = (size_t)HALF * K * 2;
    const size_t tstep = 2 * hstep;
    const unsigned ldsw = (unsigned)wid * 1024u;
    const int aoff = lds_byte(wr * 64 + fr, fq * 8), boff = lds_byte(wc * 32 + fr, fq * 8);
#define PG8_SA(b, h) (((b) * 2 + (h)) * HTB)
#define PG8_SB(b, h) ((4 + (b) * 2 + (h)) * HTB)
#define PG8_STAGE(bufoff, gbase, voff) do { _Pragma("unroll") for (int _i = 0; _i < 2; ++_i) \
        __builtin_amdgcn_global_load_lds((const unsigned*)((const char*)(gbase) + (voff)[_i]), (PG8_LAS unsigned*)(lds + (bufoff) + ldsw + _i * 8192), 16, 0, 0); } while (0)
#define PG8_LDA(dst, b, h) do { _Pragma("unroll") for (int m = 0; m < 4; ++m) _Pragma("unroll") for (int k = 0; k < 2; ++k) dst[m][k] = *(const PG8_LAS bf16x8*)(lds + PG8_SA(b, h) + aoff + m * 2048 + k * 1024); } while (0)
#define PG8_LDB(dst, b, h) do { _Pragma("unroll") for (int n = 0; n < 2; ++n) _Pragma("unroll") for (int k = 0; k < 2; ++k) dst[n][k] = *(const PG8_LAS bf16x8*)(lds + PG8_SB(b, h) + boff + n * 2048 + k * 1024); } while (0)
#define PG8_MMA(ai, bj, At, Bt) do { __builtin_amdgcn_s_setprio(1); _Pragma("unroll") for (int m = 0; m < 4; ++m) _Pragma("unroll") for (int n = 0; n < 2; ++n) _Pragma("unroll") for (int k = 0; k < 2; ++k) \
        acc[ai][bj][m][n] = __builtin_amdgcn_mfma_f32_16x16x32_bf16(Bt[n][k], At[m][k], acc[ai][bj][m][n], 0, 0, 0); __builtin_amdgcn_s_setprio(0); } while (0)
#define PG8_WAIT_V(n) asm volatile("s_waitcnt vmcnt(" #n ")" ::: "memory")
#define PG8_WAIT_L(n) asm volatile("s_waitcnt lgkmcnt(" #n ")" ::: "memory")
#define PG8_BAR __builtin_amdgcn_s_barrier()
#define PG8_SCHED __builtin_amdgcn_sched_barrier(0)
    Unit cur, nxt; int ui = 0;
    if (!S.next(0, cur)) return;
    f32x4 acc[2][2][4][2];
#pragma unroll
    for (int a = 0; a < 2; ++a)
#pragma unroll
        for (int b = 0; b < 2; ++b)
#pragma unroll
            for (int m = 0; m < 4; ++m)
#pragma unroll
                for (int n = 0; n < 2; ++n) acc[a][b][m][n] = (f32x4){0.f, 0.f, 0.f, 0.f};
    bf16x8 At[4][2], B0[2][2], B1[2][2];
    const char* cA = (const char*)g.A + (size_t)cur.pm * tstep; const char* cB = (const char*)g.Bt + (size_t)cur.pn * tstep;
    S.a_ready(cur);
    if constexpr (SP2) {
        PG8_STAGE(PG8_SB(0, 0), cB, voffB); PG8_STAGE(PG8_SB(0, 1), cB + hstep, voffB); PG8_STAGE(PG8_SA(0, 0), cA, voffA); PG8_STAGE(PG8_SA(0, 1), cA + hstep, voffA);
        if (wr == 1) PG8_BAR;
        PG8_WAIT_V(2); PG8_BAR;
        PG8_STAGE(PG8_SB(1, 0), cB + kstep, voffB); PG8_STAGE(PG8_SA(1, 0), cA + kstep, voffA); PG8_STAGE(PG8_SB(1, 1), cB + hstep + kstep, voffB);
        PG8_WAIT_V(6); PG8_BAR;
    } else {
        PG8_STAGE(PG8_SB(0, 0), cB, voffB); PG8_STAGE(PG8_SA(0, 0), cA, voffA); PG8_STAGE(PG8_SB(0, 1), cB + hstep, voffB); PG8_STAGE(PG8_SA(0, 1), cA + hstep, voffA);
        if (wr == 1) PG8_BAR;
        PG8_WAIT_V(4); PG8_BAR;
        PG8_STAGE(PG8_SB(1, 0), cB + kstep, voffB); PG8_STAGE(PG8_SA(1, 0), cA + kstep, voffA); PG8_STAGE(PG8_SB(1, 1), cB + hstep + kstep, voffB);
        PG8_WAIT_V(6); PG8_BAR;
    }
    for (;;) {
        const bool has_next = S.next(ui + 1, nxt);
        const char* nA = has_next ? (const char*)g.A + (size_t)nxt.pm * tstep : cA; const char* nB = has_next ? (const char*)g.Bt + (size_t)nxt.pn * tstep : cB;
        for (int t = 0; t < nt; t += 2) {
            const bool last = (t == nt - 2);
            const char* a1 = cA + (size_t)(t + 1) * kstep;
            const char* a2 = last ? nA : cA + (size_t)(t + 2) * kstep; const char* b2 = last ? nB : cB + (size_t)(t + 2) * kstep;
            const char* a3 = a2 + kstep; const char* b3 = b2 + kstep;
            if (last && has_next) S.a_ready(nxt);
            if constexpr (SP2) {
            PG8_LDB(B0, 0, 0); PG8_LDB(B1, 0, 1); PG8_SCHED; PG8_LDA(At, 0, 0); PG8_STAGE(PG8_SA(1, 1), a1 + hstep, voffA);
            PG8_WAIT_V(8); PG8_WAIT_L(0); PG8_BAR; PG8_MMA(0, 0, At, B0); PG8_MMA(0, 1, At, B1); PG8_BAR; PG8_SCHED;
            PG8_LDA(At, 0, 1); PG8_STAGE(PG8_SB(0, 0), b2, voffB); PG8_STAGE(PG8_SB(0, 1), b2 + hstep, voffB); PG8_STAGE(PG8_SA(0, 0), a2, voffA);
            PG8_WAIT_V(8); PG8_WAIT_L(0); PG8_BAR; PG8_MMA(1, 0, At, B0); PG8_MMA(1, 1, At, B1); PG8_BAR; PG8_SCHED;
            PG8_LDB(B0, 1, 0); PG8_LDB(B1, 1, 1); PG8_SCHED; PG8_LDA(At, 1, 0); PG8_STAGE(PG8_SA(0, 1), a2 + hstep, voffA);
            PG8_WAIT_V(8); PG8_WAIT_L(0); PG8_BAR; PG8_MMA(0, 0, At, B0); PG8_MMA(0, 1, At, B1); PG8_BAR; PG8_SCHED;
            PG8_LDA(At, 1, 1); PG8_STAGE(PG8_SB(1, 0), b3, voffB); PG8_STAGE(PG8_SB(1, 1), b3 + hstep, voffB); PG8_STAGE(PG8_SA(1, 0), a3, voffA);
            PG8_WAIT_V(8); PG8_WAIT_L(0); PG8_BAR; PG8_MMA(1, 0, At, B0); PG8_MMA(1, 1, At, B1); PG8_BAR; PG8_SCHED;
            } else {
            PG8_LDB(B0, 0, 0); PG8_SCHED; PG8_LDA(At, 0, 0); PG8_STAGE(PG8_SA(1, 1), a1 + hstep, voffA);
            PG8_WAIT_L(8); PG8_BAR; PG8_WAIT_L(0); PG8_MMA(0, 0, At, B0); PG8_BAR; PG8_SCHED;
            PG8_LDB(B1, 0, 1); PG8_STAGE(PG8_SB(0, 0), b2, voffB);
            PG8_BAR; PG8_WAIT_L(0); PG8_MMA(0, 1, At, B1); PG8_BAR;
            PG8_LDA(At, 0, 1); PG8_STAGE(PG8_SA(0, 0), a2, voffA);
            PG8_BAR; PG8_WAIT_L(0); PG8_MMA(1, 0, At, B0); PG8_BAR; PG8_SCHED;
            PG8_STAGE(PG8_SB(0, 1), b2 + hstep, voffB);
            PG8_WAIT_V(6); PG8_BAR; PG8_MMA(1, 1, At, B1); PG8_BAR;
            PG8_LDB(B0, 1, 0); PG8_SCHED; PG8_LDA(At, 1, 0); PG8_STAGE(PG8_SA(0, 1), a2 + hstep, voffA);
            PG8_WAIT_L(8); PG8_BAR; PG8_WAIT_L(0); PG8_MMA(0, 0, At, B0); PG8_BAR; PG8_SCHED;
            PG8_LDB(B1, 1, 1); PG8_STAGE(PG8_SB(1, 0), b3, voffB);
            PG8_BAR; PG8_WAIT_L(0); PG8_MMA(0, 1, At, B1); PG8_BAR;
            PG8_LDA(At, 1, 1); PG8_STAGE(PG8_SA(1, 0), a3, voffA);
            PG8_BAR; PG8_WAIT_L(0); PG8_MMA(1, 0, At, B0); PG8_BAR; PG8_SCHED;
            PG8_STAGE(PG8_SB(1, 1), b3 + hstep, voffB);
            PG8_WAIT_V(6); PG8_BAR; PG8_MMA(1, 1, At, B1); PG8_BAR;
            }
        }
        if constexpr (ALIGN_EPI) { if (wr == 0) PG8_BAR; }
        if constexpr (!Epi::AFTER_DRAIN) { E(acc, cur, wr, wc, fr, fq); S.done(cur); }
        if (!has_next) break;
#pragma unroll
        for (int a = 0; a < 2; ++a)
#pragma unroll
            for (int b = 0; b < 2; ++b)
#pragma unroll
                for (int m = 0; m < 4; ++m)
#pragma unroll
                    for (int n = 0; n < 2; ++n) acc[a][b][m][n] = (f32x4){0.f, 0.f, 0.f, 0.f};
        cur = nxt; cA = nA; cB = nB; ++ui;
        if constexpr (ALIGN_EPI) { if (wr == 1) PG8_BAR; }
    }
    PG8_WAIT_V(0);
    if constexpr (!ALIGN_EPI) { if (wr == 0) PG8_BAR; }
    PG8_BAR;
    if constexpr (Epi::AFTER_DRAIN) { E.fused(acc, cur, wr, wc, fr, fq, lds, wid, lane); S.done(cur); }
#undef PG8_SA
#undef PG8_SB
#undef PG8_STAGE
#undef PG8_LDA
#undef PG8_LDB
#undef PG8_MMA
#undef PG8_WAIT_V
#undef PG8_WAIT_L
#undef PG8_BAR
#undef PG8_SCHED
}
}
namespace mk {
using pg8::bf16_t; using pg8::bf16x8; using pg8::f32x4; using pg8::u32x4;
#define LAS __attribute__((address_space(3)))
#define DEV __device__ __forceinline__
typedef unsigned u32x2 __attribute__((ext_vector_type(2)));
typedef float f32x2 __attribute__((ext_vector_type(2)));

constexpr int D = 1024, SEQ = 8192, NP = 16384, NS = 128, NR = NP + NS, MT = 16640, DFF = 2816;
constexpr int EIN = 2816, OIN = 4112, OINP = 4352, NMODC = 18432;
constexpr float ALPHA = 1.41421356237309515f;
constexpr int NTHR = 512;
constexpr size_t OFF_Y = 0, OFF_YS = 16777216, OFF_PSK = 16908288, OFF_PSV = 16941056, OFF_PH = 16973824, OFF_PG = 17104896, OFF_PC = 17367040,
                 OFF_SSK = 17385472, OFF_SSV = 19482624, OFF_SH = 21579776, OFF_SG = 29968384, OFF_SC = 46745600, OUT_TOTAL = 47925248;
constexpr size_t MiB = 1u << 20;
constexpr size_t WS_CTL = 0, WS_WUP = 1 * MiB, WS_WDN = 45 * MiB, WS_WEIN = 67 * MiB, WS_WEOUT = 73 * MiB, WS_WOIN = 75 * MiB, WS_WOOUT = 84 * MiB,
                 WS_MODS = 86 * MiB, WS_X = 96 * MiB, WS_AO = 161 * MiB, WS_BIG = 194 * MiB;
constexpr size_t B_ADAT = 0, B_ACS = 36 * MiB, B_H = 0;
constexpr size_t B_QA = 0, B_QB = 17 * MiB, B_KB = 34 * MiB, B_VB = 51 * MiB, B_GB = 68 * MiB, B_LOGF = 85 * MiB, B_KA = 118 * MiB, B_VA = 123 * MiB, B_SLOC = 128 * MiB, B_DTOT = 144 * MiB;
constexpr size_t B_QKV = 0, B_GG = 98 * MiB, B_KT = 131 * MiB, B_UT = 163 * MiB, B_QKM = 195 * MiB, B_LA = 211 * MiB, B_BETA = 212 * MiB, B_HALO = 213 * MiB, B_GLAST = 218 * MiB;
constexpr size_t WS_END = WS_BIG + 219 * MiB;

DEV float bf2f(unsigned short v) { return __uint_as_float(((unsigned)v) << 16); }
DEV unsigned pk2(float lo, float hi) { typedef __bf16 bf2_t __attribute__((ext_vector_type(2))); f32x2 v = {lo, hi}; bf2_t b = __builtin_convertvector(v, bf2_t); return __builtin_bit_cast(unsigned, b); }
DEV unsigned short f2bf(float f) { return (unsigned short)(pk2(f, 0.f) & 0xffffu); }
DEV float lo16(unsigned w) { return __uint_as_float(w << 16); }
DEV float hi16(unsigned w) { return __uint_as_float(w & 0xffff0000u); }
DEV float sigm(float x) { return 1.f / (1.f + __expf(-x)); }
DEV float silu(float x) { return x / (1.f + __expf(-x)); }
DEV int modrow(int row) { return row < NP ? (row >> 13) : ((row - NP) < NS ? (row - NP) : (NS - 1)) + 2; }
DEV bf16x8 mk8(u32x2 a, u32x2 b) { u32x4 t = {a.x, a.y, b.x, b.y}; return __builtin_bit_cast(bf16x8, t); }
DEV bf16x8 mk8f(f32x4 a, f32x4 b) { u32x4 t = {pk2(a[0], a[1]), pk2(a[2], a[3]), pk2(b[0], b[1]), pk2(b[2], b[3])}; return __builtin_bit_cast(bf16x8, t); }
DEV f32x4 mfma16(bf16x8 a, bf16x8 b, f32x4 c) { return __builtin_amdgcn_mfma_f32_16x16x32_bf16(a, b, c, 0, 0, 0); }
DEV float wave_sum(float v) {
#pragma unroll
    for (int o = 1; o < 64; o <<= 1) v += __shfl_xor(v, o);
    return v; }
DEV float wave_max(float v) {
#pragma unroll
    for (int o = 1; o < 64; o <<= 1) v = fmaxf(v, __shfl_xor(v, o));
    return v; }

struct Args { const float* in[26]; float* out; unsigned char* ws; int ph_lo, ph_hi, coop, pad; };
struct Ctx { const Args& a; unsigned char* ws; float* out_;
    DEV const float* in(int k) const { return a.in[k]; }
    DEV float* out() const { return out_; }
    DEV bf16_t* WUP() const { return (bf16_t*)(ws + WS_WUP); }  DEV bf16_t* WDN() const { return (bf16_t*)(ws + WS_WDN); }
    DEV bf16_t* WEIN() const { return (bf16_t*)(ws + WS_WEIN); } DEV bf16_t* WEOUT() const { return (bf16_t*)(ws + WS_WEOUT); }
    DEV bf16_t* WOIN() const { return (bf16_t*)(ws + WS_WOIN); } DEV bf16_t* WOOUT() const { return (bf16_t*)(ws + WS_WOOUT); }
    DEV float* MODS() const { return (float*)(ws + WS_MODS); } DEV float* X() const { return (float*)(ws + WS_X); }
    DEV bf16_t* AO() const { return (bf16_t*)(ws + WS_AO); } DEV unsigned char* BIG() const { return ws + WS_BIG; }
};
enum { I_XP = 0, I_XS, I_CK, I_CV, I_SH, I_SG, I_SC, I_CP, I_CS, I_ADAW, I_ADAB, I_LNG, I_LNB, I_WUP, I_WDN, I_EIN, I_EOUT, I_SINK, I_HNG, I_LBL, I_OIN, I_OOUT, I_CONVW, I_ALOG, I_DTB, I_GNG };

struct EpiSwiGLU { static constexpr bool PERM = true, AFTER_DRAIN = false; bf16_t* H;
    __device__ __forceinline__ void operator()(const f32x4 (&acc)[2][2][4][2], const pg8::Unit& u, int wr, int wc, int fr, int fq) const {
        const int row0 = u.pm * 256 + wr * 64 + fr, col0 = u.pn * 128 + wc * 32 + 8 * fq;
#pragma unroll
        for (int ai = 0; ai < 2; ++ai)
#pragma unroll
            for (int m = 0; m < 4; ++m) { const int row = row0 + ai * 128 + m * 16;
                const f32x4 g0 = acc[ai][0][m][0], g1 = acc[ai][0][m][1], u0 = acc[ai][1][m][0], u1 = acc[ai][1][m][1];
                u32x4 w; w.x = pk2(silu(g0[0]) * u0[0], silu(g0[1]) * u0[1]); w.y = pk2(silu(g0[2]) * u0[2], silu(g0[3]) * u0[3]);
                w.z = pk2(silu(g1[0]) * u1[0], silu(g1[1]) * u1[1]); w.w = pk2(silu(g1[2]) * u1[2], silu(g1[3]) * u1[3]);
                *(u32x4*)(H + (size_t)row * DFF + col0) = w; }
    }
};
struct EpiResid { static constexpr bool PERM = false, AFTER_DRAIN = false; const float* base_p; const float* base_s; float* V; const float* gate; float gs;
    __device__ __forceinline__ void operator()(const f32x4 (&acc)[2][2][4][2], const pg8::Unit& u, int wr, int wc, int fr, int fq) const {
        const int row0 = u.pm * 256 + wr * 64 + fr, col0 = u.pn * 256 + wc * 32 + 4 * fq;
#pragma unroll
        for (int ai = 0; ai < 2; ++ai)
#pragma unroll
            for (int m = 0; m < 4; ++m) { const int row = row0 + ai * 128 + m * 16; if (row >= NR) continue;
                const float* brow = row < NP ? base_p + (size_t)row * D : base_s + (size_t)(row - NP) * D; const float* grow = gate + (size_t)modrow(row) * NMODC;
#pragma unroll
                for (int bj = 0; bj < 2; ++bj)
#pragma unroll
                    for (int n = 0; n < 2; ++n) { const int col = col0 + bj * 128 + n * 16; const f32x4 bv = *(const f32x4*)(brow + col), gv = *(const f32x4*)(grow + col);
                        *(f32x4*)(V + (size_t)row * D + col) = bv * ALPHA + gv * acc[ai][bj][m][n] * gs; } }
    }
};
struct EpiMods { static constexpr bool PERM = false, AFTER_DRAIN = false; float* MODS; const float* bias;
    __device__ __forceinline__ void operator()(const f32x4 (&acc)[2][2][4][2], const pg8::Unit& u, int wr, int wc, int fr, int fq) const {
        const int row0 = u.pm * 256 + wr * 64 + fr, col0 = u.pn * 256 + wc * 32 + 4 * fq;
#pragma unroll
        for (int ai = 0; ai < 2; ++ai)
#pragma unroll
            for (int m = 0; m < 4; ++m) { const int row = row0 + ai * 128 + m * 16; if (row >= 130) continue;
#pragma unroll
                for (int bj = 0; bj < 2; ++bj)
#pragma unroll
                    for (int n = 0; n < 2; ++n) { const int col = col0 + bj * 128 + n * 16; *(f32x4*)(MODS + (size_t)row * NMODC + col) = acc[ai][bj][m][n] + *(const f32x4*)(bias + col); } }
    }
};
DEV u32x4 pack8(f32x4 a, f32x4 b) { u32x4 w; w.x = pk2(a[0], a[1]); w.y = pk2(a[2], a[3]); w.z = pk2(b[0], b[1]); w.w = pk2(b[2], b[3]); return w; }
struct EpiEvenIn { static constexpr bool PERM = true, AFTER_DRAIN = false;
    bf16_t *QA, *KA, *VA, *QB, *KB, *VB, *GB; float* LOGF; const float* lbl; float* out;
    __device__ __forceinline__ void operator()(const f32x4 (&acc)[2][2][4][2], const pg8::Unit& u, int wr, int wc, int fr, int fq) const {
        const int row0 = u.pm * 256 + wr * 64 + fr, pn = u.pn;
#pragma unroll
        for (int ai = 0; ai < 2; ++ai)
#pragma unroll
            for (int m = 0; m < 4; ++m) { const int row = row0 + ai * 128 + m * 16; if (row >= NR) continue;
#pragma unroll
                for (int bj = 0; bj < 2; ++bj) { const int c = pn * 256 + bj * 128 + wc * 32 + 8 * fq; const f32x4 a0 = acc[ai][bj][m][0], a1 = acc[ai][bj][m][1];
                    if (pn < 2) { *(u32x4*)(QA + (size_t)row * 512 + c) = pack8(a0, a1); }
                    else if (pn == 2) { const int cc = c - 512 - bj * 128; bf16_t* dst = bj == 0 ? KA : VA; *(u32x4*)(dst + (size_t)row * 128 + cc) = pack8(a0, a1);
                        if (row < NP && (row & 8191) >= 8064) { float* o = out + (bj == 0 ? OFF_PSK : OFF_PSV) + (size_t)((row >> 13) * 128 + ((row & 8191) - 8064)) * 128 + cc; *(f32x4*)o = a0; *(f32x4*)(o + 4) = a1; } }
                    else if (pn < 5) { const int cc = c - 768; f32x4 s0, s1;
#pragma unroll
                        for (int e = 0; e < 4; ++e) { s0[e] = silu(a0[e]); s1[e] = silu(a1[e]); }
                        *(u32x4*)(QB + (size_t)row * 512 + cc) = pack8(s0, s1); }
                    else if (pn < 7) { const int cc = c - 1280; f32x4 l0, l1, k0, k1; const f32x4 la0 = *(const f32x4*)(lbl + cc), la1 = *(const f32x4*)(lbl + cc + 4), lb0 = *(const f32x4*)(lbl + 512 + cc), lb1 = *(const f32x4*)(lbl + 512 + cc + 4);
#pragma unroll
                        for (int e = 0; e < 4; ++e) { const float p0 = sigm(lb0[e] - la0[e]), p1 = sigm(lb1[e] - la1[e]); const float f0 = p0 + (1.f - p0) * sigm(a0[e]), f1 = p1 + (1.f - p1) * sigm(a1[e]);
                            l0[e] = __logf(f0); l1[e] = __logf(f1); k0[e] = 1.f - f0; k1[e] = 1.f - f1; }
                        *(f32x4*)(LOGF + (size_t)row * 512 + cc) = l0; *(f32x4*)(LOGF + (size_t)row * 512 + cc + 4) = l1; *(u32x4*)(KB + (size_t)row * 512 + cc) = pack8(k0, k1); }
                    else if (pn < 9) { const int cc = c - 1792; *(u32x4*)(VB + (size_t)row * 512 + cc) = pack8(a0, a1); }
                    else { const int cc = c - 2304; f32x4 s0, s1;
#pragma unroll
                        for (int e = 0; e < 4; ++e) { s0[e] = silu(a0[e]); s1[e] = silu(a1[e]); }
                        *(u32x4*)(GB + (size_t)row * 512 + cc) = pack8(s0, s1); }
                } }
    }
};
struct EpiOddIn { static constexpr bool PERM = true, AFTER_DRAIN = false;
    bf16_t *QKV, *GG, *HALO; float *LA, *BETA; const float *alog, *dtb; float* out;
    __device__ __forceinline__ void operator()(const f32x4 (&acc)[2][2][4][2], const pg8::Unit& u, int wr, int wc, int fr, int fq) const {
        const int row0 = u.pm * 256 + wr * 64 + fr, pn = u.pn;
#pragma unroll
        for (int ai = 0; ai < 2; ++ai)
#pragma unroll
            for (int m = 0; m < 4; ++m) { const int row = row0 + ai * 128 + m * 16; if (row >= NR) continue;
#pragma unroll
                for (int bj = 0; bj < 2; ++bj) { const int c = pn * 256 + bj * 128 + wc * 32 + 8 * fq; const f32x4 a0 = acc[ai][bj][m][0], a1 = acc[ai][bj][m][1];
                    if (pn < 12) { const u32x4 w = pack8(a0, a1); *(u32x4*)(QKV + (size_t)row * 3072 + c) = w;
                        if (row < NP) { if ((row & 63) >= 61) *(u32x4*)(HALO + ((size_t)(row >> 6) * 3 + ((row & 63) - 61)) * 3072 + c) = w;
                            if ((row & 8191) >= 8189) { float* o = out + OFF_PC + ((size_t)(row >> 13) * 3 + ((row & 8191) - 8189)) * 3072 + c; *(f32x4*)o = a0; *(f32x4*)(o + 4) = a1; } }
                        else { float* o = out + OFF_SC + ((size_t)(row - NP) * 3 + 2) * 3072 + c; *(f32x4*)o = a0; *(f32x4*)(o + 4) = a1; } }
                    else if (pn < 16) { const int cc = c - 3072; f32x4 s0, s1;
#pragma unroll
                        for (int e = 0; e < 4; ++e) { s0[e] = silu(a0[e]); s1[e] = silu(a1[e]); }
                        *(u32x4*)(GG + (size_t)row * 1024 + cc) = pack8(s0, s1); }
                    else if (bj == 0 && wc == 0 && fq < 2) {
                        if (fq == 0) { f32x4 r0, r1; const f32x4 al0 = *(const f32x4*)alog, al1 = *(const f32x4*)(alog + 4), d0 = *(const f32x4*)dtb, d1 = *(const f32x4*)(dtb + 4);
#pragma unroll
                            for (int e = 0; e < 4; ++e) { const float x0 = a0[e] + d0[e], x1 = a1[e] + d1[e]; const float sp0 = x0 > 20.f ? x0 : log1pf(__expf(x0)), sp1 = x1 > 20.f ? x1 : log1pf(__expf(x1));
                                r0[e] = -__expf(al0[e]) * sp0; r1[e] = -__expf(al1[e]) * sp1; }
                            *(f32x4*)(LA + (size_t)row * 8) = r0; *(f32x4*)(LA + (size_t)row * 8 + 4) = r1; }
                        else { f32x4 r0, r1;
#pragma unroll
                            for (int e = 0; e < 4; ++e) { r0[e] = sigm(a0[e]); r1[e] = sigm(a1[e]); }
                            *(f32x4*)(BETA + (size_t)row * 8) = r0; *(f32x4*)(BETA + (size_t)row * 8 + 4) = r1; } }
                } }
    }
};
DEV void transpose_item(const float* W, int Nsrc, int nvalid, int k0, int n0, bf16_t* WT, int K, int drow0, LAS float* scr, int lane) {
    const int n = n0 + (lane & 31); const bool ok = n < nvalid;
#pragma unroll 8
    for (int i = 0; i < 32; ++i) { const int kk = 2 * i + (lane >> 5); scr[kk * 33 + (lane & 31)] = ok ? W[(size_t)(k0 + kk) * Nsrc + n] : 0.f; }
    asm volatile("s_waitcnt lgkmcnt(0)" ::: "memory");
    const int c = lane & 7;
#pragma unroll
    for (int j = 0; j < 4; ++j) { const int nn = (lane >> 3) + 8 * j; const LAS float* s = scr + (8 * c) * 33 + nn;
        u32x4 o; o.x = pk2(s[0 * 33], s[1 * 33]); o.y = pk2(s[2 * 33], s[3 * 33]); o.z = pk2(s[4 * 33], s[5 * 33]); o.w = pk2(s[6 * 33], s[7 * 33]);
        *(u32x4*)(WT + (size_t)(drow0 + nn) * K + k0 + 8 * c) = o; }
    asm volatile("s_waitcnt lgkmcnt(0)" ::: "memory");
}
DEV void phase_prologue(const Ctx& c, LAS char* L, int gw, int NGW, int wid, int lane) {
    LAS float* scr = (LAS float*)(L + wid * 16384);
    constexpr int NI_UP = 16 * 176, NI_DN = 44 * 32, NI_EIN = 16 * 88, NI_SQ = 16 * 32, NI_OIN = 16 * 136, NI_ADA = 16 * 288;
    constexpr int NITEMS = 4 * NI_UP + 4 * NI_DN + NI_EIN + NI_SQ + NI_OIN + NI_SQ + 2 * NI_ADA;
    bf16_t* ADAT = (bf16_t*)(c.BIG() + B_ADAT);
    for (int it = gw; it < NITEMS; it += NGW) {
        int r = it;
        if (r < 4 * NI_UP) { const int mi = r / NI_UP; r -= mi * NI_UP; const int kb = r / 176, nb = r % 176, n0 = nb * 32;
            const int drow = n0 < DFF ? 256 * (n0 / 128) + (n0 % 128) : 256 * ((n0 - DFF) / 128) + 128 + ((n0 - DFF) % 128);
            transpose_item(c.in(I_WUP) + (size_t)mi * D * 2 * DFF, 2 * DFF, 2 * DFF, 64 * kb, n0, c.WUP() + (size_t)mi * 2 * DFF * D, D, drow, scr, lane); continue; }
        r -= 4 * NI_UP;
        if (r < 4 * NI_DN) { const int mi = r / NI_DN; r -= mi * NI_DN; const int kb = r / 32, nb = r % 32;
            transpose_item(c.in(I_WDN) + (size_t)mi * DFF * D, D, D, 64 * kb, 32 * nb, c.WDN() + (size_t)mi * D * DFF, DFF, 32 * nb, scr, lane); continue; }
        r -= 4 * NI_DN;
        if (r < NI_EIN) { const int kb = r / 88, nb = r % 88; transpose_item(c.in(I_EIN), EIN, EIN, 64 * kb, 32 * nb, c.WEIN(), D, 32 * nb, scr, lane); continue; }
        r -= NI_EIN;
        if (r < NI_SQ) { const int kb = r / 32, nb = r % 32; transpose_item(c.in(I_EOUT), D, D, 64 * kb, 32 * nb, c.WEOUT(), D, 32 * nb, scr, lane); continue; }
        r -= NI_SQ;
        if (r < NI_OIN) { const int kb = r / 136, nb = r % 136; transpose_item(c.in(I_OIN), OIN, OIN, 64 * kb, 32 * nb, c.WOIN(), D, 32 * nb, scr, lane); continue; }
        r -= NI_OIN;
        if (r < NI_SQ) { const int kb = r / 32, nb = r % 32; transpose_item(c.in(I_OOUT), D, D, 64 * kb, 32 * nb, c.WOOUT(), D, 32 * nb, scr, lane); continue; }
        r -= NI_SQ;
        { const int l = r / NI_ADA; r -= l * NI_ADA; const int kb = r / 288, nb = r % 288;
          transpose_item(c.in(I_ADAW) + (size_t)l * D * 9216, 9216, 9216, 64 * kb, 32 * nb, ADAT, D, l * 9216 + 32 * nb, scr, lane); }
    }
    bf16_t* ACS = (bf16_t*)(c.BIG() + B_ACS);
    for (int row = gw; row < 256 + (MT - NR); row += NGW) {
        if (row < 256) { const float* src = row < 2 ? c.in(I_CP) + row * D : (row < 130 ? c.in(I_CS) + (size_t)(row - 2) * D : nullptr);
#pragma unroll
            for (int j = 0; j < 4; ++j) { f32x4 v = {0.f, 0.f, 0.f, 0.f}; if (src) v = *(const f32x4*)(src + 256 * j + 4 * lane);
                u32x2 w; w.x = pk2(silu(v[0]), silu(v[1])); w.y = pk2(silu(v[2]), silu(v[3])); *(u32x2*)(ACS + (size_t)row * D + 256 * j + 4 * lane) = w; } }
        else { const int r2 = NR + (row - 256);
#pragma unroll
            for (int j = 0; j < 4; ++j) *(u32x2*)(c.AO() + (size_t)r2 * D + 256 * j + 4 * lane) = (u32x2){0u, 0u}; }
    }
}
DEV void phase_mod0(const Ctx& c, int gw, int NGW, int lane) {
    for (int row = gw; row < NR; row += NGW) {
        const float* xr = row < NP ? c.in(I_XP) + (size_t)row * D : c.in(I_XS) + (size_t)(row - NP) * D;
        const float* mr = c.MODS() + (size_t)modrow(row) * NMODC;
#pragma unroll
        for (int j = 0; j < 4; ++j) { const int col = 256 * j + 4 * lane; const f32x4 v = *(const f32x4*)(xr + col), sh = *(const f32x4*)(mr + col), sc = *(const f32x4*)(mr + 1024 + col);
            const f32x4 y = v * (sc + 1.f) + sh; u32x2 w; w.x = pk2(y[0], y[1]); w.y = pk2(y[2], y[3]); *(u32x2*)(c.AO() + (size_t)row * D + col) = w; }
    }
}
DEV void phase_ln(const Ctx& c, int lni  , int nmod  , int gw, int NGW, int lane) {
    const float* gp = c.in(I_LNG) + lni * D; const float* bp = c.in(I_LNB) + lni * D;
    for (int row = gw; row < NR; row += NGW) {
        float* xr = c.X() + (size_t)row * D; f32x4 v[4]; float s = 0.f;
#pragma unroll
        for (int j = 0; j < 4; ++j) { v[j] = *(const f32x4*)(xr + 256 * j + 4 * lane); s += (v[j][0] + v[j][1]) + (v[j][2] + v[j][3]); }
        const float mean = wave_sum(s) * (1.f / D); float s2 = 0.f;
#pragma unroll
        for (int j = 0; j < 4; ++j) { v[j] = v[j] - mean; s2 += (v[j][0] * v[j][0] + v[j][1] * v[j][1]) + (v[j][2] * v[j][2] + v[j][3] * v[j][3]); }
        const float rstd = 1.f / sqrtf(wave_sum(s2) * (1.f / D) + 1e-5f);
        float* orow = nmod < 0 ? (row < NP ? c.out() + OFF_Y + (size_t)row * D : c.out() + OFF_YS + (size_t)(row - NP) * D) : xr;
        const float* mr = c.MODS() + (size_t)modrow(row) * NMODC + (nmod < 0 ? 0 : nmod) * 1024;
#pragma unroll
        for (int j = 0; j < 4; ++j) { const int col = 256 * j + 4 * lane; const f32x4 y = v[j] * rstd * *(const f32x4*)(gp + col) + *(const f32x4*)(bp + col);
            *(f32x4*)(orow + col) = y;
            if (nmod >= 0) { const f32x4 sh = *(const f32x4*)(mr + col), sc = *(const f32x4*)(mr + 1024 + col); const f32x4 z = y * (sc + 1.f) + sh;
                u32x2 w; w.x = pk2(z[0], z[1]); w.y = pk2(z[2], z[3]); *(u32x2*)(c.AO() + (size_t)row * D + col) = w; } }
    }
}
DEV void swa_unit(const Ctx& c, int unit, LAS char* L, int tid, int wid, int lane) {
    const int qb = unit & 63, kv = (unit >> 6) & 1, b = unit >> 7, g = lane >> 4, i = lane & 15;
    const bf16_t* QA = (const bf16_t*)(c.BIG() + B_QA); const bf16_t* KA = (const bf16_t*)(c.BIG() + B_KA); const bf16_t* VA = (const bf16_t*)(c.BIG() + B_VA);
    LAS bf16_t* Ks = (LAS bf16_t*)L; LAS bf16_t* Vt = (LAS bf16_t*)(L + 36864);
    const long row0 = (long)b * SEQ + (qb - 1) * 128;
#pragma unroll
    for (int it = 0; it < 4; ++it) { const int idx = it * NTHR + tid, key = idx >> 3, ch = idx & 7; const bool ok = qb > 0 || key >= 128;
        u32x4 kq = {0u, 0u, 0u, 0u}, vq = {0u, 0u, 0u, 0u};
        if (ok) { kq = *(const u32x4*)(KA + (row0 + key) * 128 + kv * 64 + ch * 8); vq = *(const u32x4*)(VA + (row0 + key) * 128 + kv * 64 + ch * 8); }
        *(LAS u32x4*)(Ks + key * 72 + ch * 8) = kq;
#pragma unroll
        for (int e = 0; e < 4; ++e) { const unsigned w = vq[e]; Vt[(ch * 8 + 2 * e) * 264 + key] = (bf16_t)(w & 0xffffu); Vt[(ch * 8 + 2 * e + 1) * 264 + key] = (bf16_t)(w >> 16); } }
    __syncthreads();
    const int g4 = wid >> 1, qh = wid & 1, h = kv * 4 + g4;
    const float slope = exp2f(-(float)(h + 1)), sink = c.in(I_SINK)[h];
#pragma unroll 1
    for (int st = 0; st < 4; ++st) {
        const int q0 = qh * 64 + st * 16; const long qrow = (long)b * SEQ + qb * 128 + q0 + i;
        const bf16x8 qf0 = *(const bf16x8*)(QA + qrow * 512 + h * 64 + 8 * g), qf1 = *(const bf16x8*)(QA + qrow * 512 + h * 64 + 32 + 8 * g);
        f32x4 s[9]; float m = sink;
#pragma unroll
        for (int j = 0; j < 9; ++j) { const int key = q0 + 16 * j + i;
            const bf16x8 k0 = *(const LAS bf16x8*)(Ks + key * 72 + 8 * g), k1 = *(const LAS bf16x8*)(Ks + key * 72 + 32 + 8 * g);
            f32x4 a = {0.f, 0.f, 0.f, 0.f}; a = mfma16(k0, qf0, a); a = mfma16(k1, qf1, a);
#pragma unroll
            for (int r = 0; r < 4; ++r) { const int kidx = q0 + 16 * j + 4 * g + r, dist = 128 + i - 16 * j - 4 * g - r; const bool ok = dist >= 0 && dist < 128 && (qb > 0 || kidx >= 128);
                const float v = ok ? a[r] * 0.125f - slope * (float)dist : -INFINITY; a[r] = v; m = fmaxf(m, v); }
            s[j] = a; }
        m = fmaxf(m, __shfl_xor(m, 16)); m = fmaxf(m, __shfl_xor(m, 32));
        float sum = 0.f;
#pragma unroll
        for (int j = 0; j < 9; ++j)
#pragma unroll
            for (int r = 0; r < 4; ++r) { const float p = __expf(s[j][r] - m); s[j][r] = p; sum += p; }
        sum += __shfl_xor(sum, 16); sum += __shfl_xor(sum, 32); sum += __expf(sink - m);
        const float inv = 1.f / sum;
#pragma unroll
        for (int dt = 0; dt < 4; ++dt) { f32x4 o = {0.f, 0.f, 0.f, 0.f};
#pragma unroll
            for (int kk = 0; kk < 5; ++kk) { const LAS bf16_t* vp = Vt + (16 * dt + i) * 264 + q0 + 32 * kk + 4 * g;
                const u32x2 alo = *(const LAS u32x2*)vp; u32x2 ahi = {0u, 0u}; f32x4 phi = {0.f, 0.f, 0.f, 0.f};
                if (kk < 4) { ahi = *(const LAS u32x2*)(vp + 16); phi = s[2 * kk + 1]; }
                o = mfma16(mk8(alo, ahi), mk8f(s[2 * kk], phi), o); }
            u32x2 w; w.x = pk2(o[0] * inv, o[1] * inv); w.y = pk2(o[2] * inv, o[3] * inv);
            *(u32x2*)(c.AO() + qrow * D + h * 64 + 16 * dt + 4 * g) = w; }
    }
}
DEV void samp_swa_unit(const Ctx& c, int bi, LAS char* L, int tid, int wid, int lane) {
    const bf16_t* QA = (const bf16_t*)(c.BIG() + B_QA); const bf16_t* KA = (const bf16_t*)(c.BIG() + B_KA); const bf16_t* VA = (const bf16_t*)(c.BIG() + B_VA);
    const long row = NP + bi; LAS float* qs = (LAS float*)L; LAS float* ps = qs + 512;
    qs[tid] = bf2f(QA[row * 512 + tid]) * 0.125f;
    __syncthreads();
    const int h = wid, kv = h >> 2; const float slope = exp2f(-(float)(h + 1)), sink = c.in(I_SINK)[h];
    const float* ck = c.in(I_CK) + (size_t)bi * 128 * 128; const float* cv = c.in(I_CV) + (size_t)bi * 128 * 128;
    float sc[2];
#pragma unroll
    for (int hf = 0; hf < 2; ++hf) { const int j = lane + 64 * hf; const float* kr = ck + j * 128 + kv * 64; float dot = 0.f;
#pragma unroll
        for (int d = 0; d < 64; d += 4) { const f32x4 kx = *(const f32x4*)(kr + d); const f32x4 qx = *(const LAS f32x4*)(qs + h * 64 + d); dot += kx[0] * qx[0] + kx[1] * qx[1] + kx[2] * qx[2] + kx[3] * qx[3]; }
        sc[hf] = j >= 1 ? dot - slope * (float)(128 - j) : -INFINITY; }
    const float scn = wave_sum(bf2f(KA[row * 128 + kv * 64 + lane]) * qs[h * 64 + lane]);
    const float m = fmaxf(fmaxf(sink, scn), wave_max(fmaxf(sc[0], sc[1])));
    const float p0 = __expf(sc[0] - m), p1 = __expf(sc[1] - m), pn = __expf(scn - m);
    const float l = wave_sum(p0 + p1) + pn + __expf(sink - m);
    ps[h * 132 + lane] = p0; ps[h * 132 + 64 + lane] = p1;
    __syncthreads();
    float o = pn * bf2f(VA[row * 128 + kv * 64 + lane]);
#pragma unroll 8
    for (int j = 1; j < 128; ++j) o += ps[h * 132 + j] * cv[j * 128 + kv * 64 + lane];
    c.AO()[row * D + h * 64 + lane] = f2bf(o / l);
    float* sk = c.out() + OFF_SSK + (size_t)bi * 128 * 128; float* sv = c.out() + OFF_SSV + (size_t)bi * 128 * 128;
    for (int idx = tid; idx < 127 * 128 / 4; idx += NTHR) { *(f32x4*)(sk + idx * 4) = *(const f32x4*)(ck + 128 + idx * 4); *(f32x4*)(sv + idx * 4) = *(const f32x4*)(cv + 128 + idx * 4); }
    if (tid < 128) { sk[127 * 128 + tid] = bf2f(KA[row * 128 + tid]); sv[127 * 128 + tid] = bf2f(VA[row * 128 + tid]); }
}
DEV void samp_hgrn_unit(const Ctx& c, int unit, LAS char* L, int tid, int wid, int lane) {
    const int bi = unit >> 2, h = unit & 3; const long row = NP + bi;
    const bf16_t* QB = (const bf16_t*)(c.BIG() + B_QB); const bf16_t* KB = (const bf16_t*)(c.BIG() + B_KB); const bf16_t* VB = (const bf16_t*)(c.BIG() + B_VB); const bf16_t* GB = (const bf16_t*)(c.BIG() + B_GB);
    const float* LOGF = (const float*)(c.BIG() + B_LOGF);
    LAS float* red = (LAS float*)L; LAS float* red2 = red + 512;
    const int dv = tid & 127, kg = tid >> 7;
    const float v = bf2f(VB[row * 512 + h * 128 + dv]);
    const float* S0 = c.in(I_SH) + ((size_t)(bi * 4 + h) * 128) * 128; float* Sn = c.out() + OFF_SH + ((size_t)(bi * 4 + h) * 128) * 128;
    float part = 0.f;
#pragma unroll 8
    for (int kk = 0; kk < 32; ++kk) { const int kd = kg * 32 + kk; const long ix = row * 512 + h * 128 + kd;
        const float f = __expf(LOGF[ix]), kval = bf2f(KB[ix]), qv = bf2f(QB[ix]);
        const float s = f * S0[kd * 128 + dv] + kval * v; Sn[kd * 128 + dv] = s; part += qv * s; }
    red[kg * 128 + dv] = part;
    __syncthreads();
    float o = 0.f, ss = 0.f;
    if (tid < 128) { o = red[dv] + red[128 + dv] + red[256 + dv] + red[384 + dv]; ss = wave_sum(o * o); if (lane == 0) red2[wid] = ss; }
    __syncthreads();
    if (tid < 128) { const float tot = red2[0] + red2[1]; const float rstd = 1.f / sqrtf(tot * (1.f / 128.f) + 1e-6f);
        c.AO()[row * D + 512 + h * 128 + dv] = f2bf(o * rstd * c.in(I_HNG)[dv] * bf2f(GB[row * 512 + h * 128 + dv])); }
}
DEV void hgrn_unit(const Ctx& c, int unit, bool pass3, LAS char* L, int tid, int wid, int lane) {
    const int sc = unit & 31, h = (unit >> 5) & 3, b = unit >> 7, g = lane >> 4, i = lane & 15, w = wid;
    const bf16_t* QB = (const bf16_t*)(c.BIG() + B_QB); const bf16_t* KB = (const bf16_t*)(c.BIG() + B_KB); const bf16_t* VB = (const bf16_t*)(c.BIG() + B_VB); const bf16_t* GB = (const bf16_t*)(c.BIG() + B_GB);
    const float* LOGF = (const float*)(c.BIG() + B_LOGF); float* SLOC = (float*)(c.BIG() + B_SLOC); float* DTOT = (float*)(c.BIG() + B_DTOT);
    LAS float* Af = (LAS float*)L; LAS bf16_t* Qs = (LAS bf16_t*)(L + 16384); LAS bf16_t* Ks = (LAS bf16_t*)(L + 25088); LAS bf16_t* KTs = (LAS bf16_t*)(L + 33792);
    LAS bf16_t* VTs = (LAS bf16_t*)(L + 44032); LAS float* Dv = (LAS float*)(L + 54272); LAS float* sumA = (LAS float*)(L + 54784); LAS float* red = (LAS float*)(L + 55296);
    const long rowbase = (long)b * SEQ + sc * 256;
    f32x4 S[8];
#pragma unroll
    for (int mt = 0; mt < 8; ++mt) S[mt] = (f32x4){0.f, 0.f, 0.f, 0.f};
    LAS float* Sl = (LAS float*)(L + 65536);
    if (pass3) {
        f32x4 acc[8];
#pragma unroll
        for (int it = 0; it < 8; ++it) acc[it] = (f32x4){0.f, 0.f, 0.f, 0.f};
#pragma unroll 1
        for (int j = 0; j < sc; ++j) { const float* sl = SLOC + (size_t)(unit - sc + j) * 16384; const float* dt = DTOT + (size_t)(unit - sc + j) * 128;
#pragma unroll
            for (int it = 0; it < 8; ++it) { const int idx = it * NTHR + tid; const float d = dt[idx >> 5]; acc[it] = acc[it] * d + *(const f32x4*)(sl + idx * 4); } }
#pragma unroll
        for (int it = 0; it < 8; ++it) *(LAS f32x4*)(Sl + (it * NTHR + tid) * 4) = acc[it];
        __syncthreads();
#pragma unroll
        for (int mt = 0; mt < 8; ++mt)
#pragma unroll
            for (int r = 0; r < 4; ++r) S[mt][r] = Sl[(16 * mt + 4 * g + r) * 128 + 16 * w + i];
    }
    if (tid < 128) sumA[tid] = 0.f;
#pragma unroll 1
    for (int ch = 0; ch < 8; ++ch) {
        const long r0 = rowbase + ch * 32;
#pragma unroll
        for (int it = 0; it < 2; ++it) { const int idx = it * NTHR + tid, t = idx >> 5, c4 = idx & 31; *(LAS f32x4*)(Af + t * 128 + c4 * 4) = *(const f32x4*)(LOGF + (r0 + t) * 512 + h * 128 + c4 * 4); }
        __syncthreads();
        if (tid < 128) { float a = 0.f;
#pragma unroll 8
            for (int t = 0; t < 32; ++t) { a += Af[t * 128 + tid]; Af[t * 128 + tid] = a; }
            Dv[tid] = __expf(a); sumA[tid] += a; }
        __syncthreads();
        { const int t = tid >> 4, kd0 = (tid & 15) * 8; const long ix = (r0 + t) * 512 + h * 128 + kd0;
          const u32x4 q8 = *(const u32x4*)(QB + ix), k8 = *(const u32x4*)(KB + ix), v8 = *(const u32x4*)(VB + ix);
          const f32x4 a0 = *(const LAS f32x4*)(Af + t * 128 + kd0), a1 = *(const LAS f32x4*)(Af + t * 128 + kd0 + 4);
          float qt[8], kt[8];
#pragma unroll
          for (int e = 0; e < 8; ++e) { const float a = e < 4 ? a0[e & 3] : a1[e & 3]; const unsigned qw = q8[e >> 1], kw = k8[e >> 1];
              const float qv = (e & 1) ? hi16(qw) : lo16(qw), kv = (e & 1) ? hi16(kw) : lo16(kw); qt[e] = qv * __expf(a); kt[e] = kv * __expf(-a); }
          u32x4 qo, ko;
#pragma unroll
          for (int e = 0; e < 4; ++e) { qo[e] = pk2(qt[2 * e], qt[2 * e + 1]); ko[e] = pk2(kt[2 * e], kt[2 * e + 1]); }
          *(LAS u32x4*)(Qs + t * 136 + kd0) = qo; *(LAS u32x4*)(Ks + t * 136 + kd0) = ko;
#pragma unroll
          for (int e = 0; e < 4; ++e) { KTs[(kd0 + 2 * e) * 40 + t] = (bf16_t)(ko[e] & 0xffffu); KTs[(kd0 + 2 * e + 1) * 40 + t] = (bf16_t)(ko[e] >> 16);
              VTs[(kd0 + 2 * e) * 40 + t] = (bf16_t)(v8[e] & 0xffffu); VTs[(kd0 + 2 * e + 1) * 40 + t] = (bf16_t)(v8[e] >> 16); } }
        __syncthreads();
        f32x4 oT0 = {0.f, 0.f, 0.f, 0.f}, oT1 = {0.f, 0.f, 0.f, 0.f};
        if (pass3) {
            f32x4 P00 = {0.f, 0.f, 0.f, 0.f}, P01 = P00, P11 = P00;
#pragma unroll
            for (int kk = 0; kk < 4; ++kk) { const bf16x8 a0 = *(const LAS bf16x8*)(Ks + i * 136 + 32 * kk + 8 * g), a1 = *(const LAS bf16x8*)(Ks + (16 + i) * 136 + 32 * kk + 8 * g);
                const bf16x8 b0 = *(const LAS bf16x8*)(Qs + i * 136 + 32 * kk + 8 * g), b1 = *(const LAS bf16x8*)(Qs + (16 + i) * 136 + 32 * kk + 8 * g);
                P00 = mfma16(a0, b0, P00); P01 = mfma16(a0, b1, P01); P11 = mfma16(a1, b1, P11); }
#pragma unroll
            for (int r = 0; r < 4; ++r) if (4 * g + r > i) { P00[r] = 0.f; P11[r] = 0.f; }
            const f32x4 z4 = {0.f, 0.f, 0.f, 0.f};
            const bf16x8 pf0 = mk8f(P00, z4), pf1 = mk8f(P01, P11);
            const bf16x8 va = mk8(*(const LAS u32x2*)(VTs + (16 * w + i) * 40 + 4 * g), *(const LAS u32x2*)(VTs + (16 * w + i) * 40 + 16 + 4 * g));
            oT0 = mfma16(va, pf0, oT0); oT1 = mfma16(va, pf1, oT1);
#pragma unroll
            for (int kk = 0; kk < 4; ++kk) { const bf16x8 sf = mk8f(S[2 * kk], S[2 * kk + 1]);
                const bf16x8 q0 = mk8(*(const LAS u32x2*)(Qs + i * 136 + 32 * kk + 4 * g), *(const LAS u32x2*)(Qs + i * 136 + 32 * kk + 16 + 4 * g));
                const bf16x8 q1 = mk8(*(const LAS u32x2*)(Qs + (16 + i) * 136 + 32 * kk + 4 * g), *(const LAS u32x2*)(Qs + (16 + i) * 136 + 32 * kk + 16 + 4 * g));
                oT0 = mfma16(sf, q0, oT0); oT1 = mfma16(sf, q1, oT1); }
        }
        { const bf16x8 vb = *(const LAS bf16x8*)(VTs + (16 * w + i) * 40 + 8 * g);
#pragma unroll
          for (int mt = 0; mt < 8; ++mt) { const bf16x8 ka = *(const LAS bf16x8*)(KTs + (16 * mt + i) * 40 + 8 * g); S[mt] = mfma16(ka, vb, S[mt]);
              const f32x4 dd = *(const LAS f32x4*)(Dv + 16 * mt + 4 * g); S[mt] = S[mt] * dd; } }
        if (pass3) {
            float ss0 = oT0[0] * oT0[0] + oT0[1] * oT0[1] + oT0[2] * oT0[2] + oT0[3] * oT0[3], ss1 = oT1[0] * oT1[0] + oT1[1] * oT1[1] + oT1[2] * oT1[2] + oT1[3] * oT1[3];
            ss0 += __shfl_xor(ss0, 16); ss0 += __shfl_xor(ss0, 32); ss1 += __shfl_xor(ss1, 16); ss1 += __shfl_xor(ss1, 32);
            if (g == 0) { red[w * 32 + i] = ss0; red[w * 32 + 16 + i] = ss1; }
            __syncthreads();
            float t0 = 0.f, t1 = 0.f;
#pragma unroll
            for (int ww = 0; ww < 8; ++ww) { t0 += red[ww * 32 + i]; t1 += red[ww * 32 + 16 + i]; }
            const float rs0 = 1.f / sqrtf(t0 * (1.f / 128.f) + 1e-6f), rs1 = 1.f / sqrtf(t1 * (1.f / 128.f) + 1e-6f);
            const int dvb = 16 * w + 4 * g; const f32x4 ng = *(const f32x4*)(c.in(I_HNG) + dvb);
#pragma unroll
            for (int tt = 0; tt < 2; ++tt) { const long row = r0 + 16 * tt + i; const u32x2 gb = *(const u32x2*)(GB + row * 512 + h * 128 + dvb); const f32x4 o = tt ? oT1 : oT0; const float rs = tt ? rs1 : rs0;
                u32x2 wv; wv.x = pk2(o[0] * rs * ng[0] * lo16(gb.x), o[1] * rs * ng[1] * hi16(gb.x)); wv.y = pk2(o[2] * rs * ng[2] * lo16(gb.y), o[3] * rs * ng[3] * hi16(gb.y));
                *(u32x2*)(c.AO() + row * D + 512 + h * 128 + dvb) = wv; }
        }
        __syncthreads();
    }
    if (!pass3 || sc == 31) {
#pragma unroll
        for (int mt = 0; mt < 8; ++mt)
#pragma unroll
            for (int r = 0; r < 4; ++r) Sl[(16 * mt + 4 * g + r) * 128 + 16 * w + i] = S[mt][r];
        __syncthreads();
        float* dst = pass3 ? c.out() + OFF_PH + (size_t)(b * 4 + h) * 16384 : SLOC + (size_t)unit * 16384;
#pragma unroll 2
        for (int it = 0; it < 8; ++it) { const int idx = it * NTHR + tid; *(f32x4*)(dst + idx * 4) = *(const LAS f32x4*)(Sl + idx * 4); }
        if (!pass3 && tid < 128) DTOT[(size_t)unit * 128 + tid] = __expf(sumA[tid]);
    }
}
DEV void conv_unit(const Ctx& c, int seg, int tid, int lane) {
    if (tid >= 384) return;
    bf16_t* QKV = (bf16_t*)(c.BIG() + B_QKV); const bf16_t* HALO = (const bf16_t*)(c.BIG() + B_HALO);
    const int col0 = tid * 8, kind = tid >> 7; const long row0 = (long)seg * 64;
    float p0[8], p1[8], p2[8], w0[8], w1[8], w2[8], w3[8];
    const float* cw = c.in(I_CONVW);
#pragma unroll
    for (int e = 0; e < 8; ++e) { w0[e] = cw[col0 + e]; w1[e] = cw[3072 + col0 + e]; w2[e] = cw[2 * 3072 + col0 + e]; w3[e] = cw[3 * 3072 + col0 + e]; p0[e] = 0.f; p1[e] = 0.f; p2[e] = 0.f; }
    if ((row0 & 8191) != 0) { const bf16_t* hp = HALO + (size_t)(seg - 1) * 3 * 3072 + col0; const u32x4 h0 = *(const u32x4*)hp, h1 = *(const u32x4*)(hp + 3072), h2 = *(const u32x4*)(hp + 6144);
#pragma unroll
        for (int e = 0; e < 4; ++e) { p0[2 * e] = lo16(h0[e]); p0[2 * e + 1] = hi16(h0[e]); p1[2 * e] = lo16(h1[e]); p1[2 * e + 1] = hi16(h1[e]); p2[2 * e] = lo16(h2[e]); p2[2 * e + 1] = hi16(h2[e]); } }
#pragma unroll 4
    for (int t = 0; t < 64; ++t) { bf16_t* p = QKV + (row0 + t) * 3072 + col0; const u32x4 x = *(const u32x4*)p; float cur[8], y[8]; float ss = 0.f;
#pragma unroll
        for (int e = 0; e < 4; ++e) { cur[2 * e] = lo16(x[e]); cur[2 * e + 1] = hi16(x[e]); }
#pragma unroll
        for (int e = 0; e < 8; ++e) { const float a = w0[e] * p0[e] + w1[e] * p1[e] + w2[e] * p2[e] + w3[e] * cur[e]; y[e] = silu(a); ss += y[e] * y[e]; p0[e] = p1[e]; p1[e] = p2[e]; p2[e] = cur[e]; }
        float scale = 1.f;
        if (kind < 2) { ss += __shfl_xor(ss, 1); ss += __shfl_xor(ss, 2); ss += __shfl_xor(ss, 4); ss += __shfl_xor(ss, 8); scale = (1.f / sqrtf(ss + 1e-6f)) * (kind == 0 ? 0.08838834764831845f : 1.f); }
        u32x4 o;
#pragma unroll
        for (int e = 0; e < 4; ++e) o[e] = pk2(y[2 * e] * scale, y[2 * e + 1] * scale);
        *(u32x4*)p = o; }
}
DEV void prep_unit(const Ctx& c, int u, LAS char* L, int tid, int wid, int lane) {
    const int ch_ = u & 127, h = (u >> 7) & 7, b = u >> 10, g = lane >> 4, i = lane & 15, w = wid;
    bf16_t* QKV = (bf16_t*)(c.BIG() + B_QKV); bf16_t* KT = (bf16_t*)(c.BIG() + B_KT); bf16_t* UT = (bf16_t*)(c.BIG() + B_UT); bf16_t* QKM = (bf16_t*)(c.BIG() + B_QKM);
    const float* LA = (const float*)(c.BIG() + B_LA); const float* BETA = (const float*)(c.BIG() + B_BETA); float* GLAST = (float*)(c.BIG() + B_GLAST);
    LAS bf16_t* Kcs = (LAS bf16_t*)L; LAS bf16_t* Qcs = (LAS bf16_t*)(L + 17408); LAS bf16_t* KbT = (LAS bf16_t*)(L + 34816); LAS bf16_t* VbT = (LAS bf16_t*)(L + 53248);
    LAS float* Lf = (LAS float*)(L + 71680); LAS bf16_t* Ts = (LAS bf16_t*)(L + 89088); LAS float* Gs = (LAS float*)(L + 98304); LAS float* Bs = (LAS float*)(L + 98560); LAS bf16_t* KdT = (LAS bf16_t*)(L + 98816);
    const long r0 = (long)b * SEQ + ch_ * 64;
    if (wid == 0) { float a = LA[(r0 + lane) * 8 + h];
#pragma unroll
        for (int o = 1; o < 64; o <<= 1) { const float t = __shfl_up(a, o); if (lane >= o) a += t; }
        Gs[lane] = a; Bs[lane] = BETA[(r0 + lane) * 8 + h]; }
    __syncthreads();
    const float Glast = Gs[63];
#pragma unroll
    for (int it = 0; it < 2; ++it) { const int idx = it * NTHR + tid, t = idx >> 4, cc = idx & 15; bf16_t* qp = QKV + (r0 + t) * 3072 + h * 128 + cc * 8;
        const u32x4 q8 = *(const u32x4*)qp, k8 = *(const u32x4*)(qp + 1024), v8 = *(const u32x4*)(qp + 2048);
        const float G = Gs[t], be = Bs[t], eg = __expf(G), egl = __expf(Glast - G), bk = be * eg;
        *(LAS u32x4*)(Kcs + t * 136 + cc * 8) = k8; *(LAS u32x4*)(Qcs + t * 136 + cc * 8) = q8;
        u32x4 qd;
#pragma unroll
        for (int e = 0; e < 4; ++e) { qd[e] = pk2(lo16(q8[e]) * eg, hi16(q8[e]) * eg);
            const float k0 = lo16(k8[e]), k1 = hi16(k8[e]), v0 = lo16(v8[e]), v1 = hi16(v8[e]); const int kd = cc * 8 + 2 * e;
            const unsigned kb = pk2(k0 * bk, k1 * bk), vb = pk2(v0 * be, v1 * be), kdd = pk2(k0 * egl, k1 * egl);
            KbT[kd * 72 + t] = (bf16_t)(kb & 0xffffu); KbT[(kd + 1) * 72 + t] = (bf16_t)(kb >> 16);
            VbT[kd * 72 + t] = (bf16_t)(vb & 0xffffu); VbT[(kd + 1) * 72 + t] = (bf16_t)(vb >> 16);
            KdT[kd * 72 + t] = (bf16_t)(kdd & 0xffffu); KdT[(kd + 1) * 72 + t] = (bf16_t)(kdd >> 16); }
        *(u32x4*)qp = qd; }
    __syncthreads();
#pragma unroll
    for (int it = 0; it < 2; ++it) { const int idx = it * NTHR + tid, kd = idx >> 3, p = idx & 7; *(u32x4*)(KT + (size_t)u * 8192 + kd * 64 + p * 8) = *(const LAS u32x4*)(KdT + kd * 72 + p * 8); }
#pragma unroll 1
    for (int id = w; id < 10; id += 8) { int ti = 0, si = id; while (si > ti) { si -= ti + 1; ++ti; }
        f32x4 kk_ = {0.f, 0.f, 0.f, 0.f}, qk_ = kk_;
#pragma unroll
        for (int ks = 0; ks < 4; ++ks) { const bf16x8 ak = *(const LAS bf16x8*)(Kcs + (16 * ti + i) * 136 + 32 * ks + 8 * g), aq = *(const LAS bf16x8*)(Qcs + (16 * ti + i) * 136 + 32 * ks + 8 * g);
            const bf16x8 bk = *(const LAS bf16x8*)(Kcs + (16 * si + i) * 136 + 32 * ks + 8 * g); kk_ = mfma16(ak, bk, kk_); qk_ = mfma16(aq, bk, qk_); }
        const int s = 16 * si + i; const float Gsv = Gs[s];
#pragma unroll
        for (int r = 0; r < 4; ++r) { const int t = 16 * ti + 4 * g + r; const float dec = __expf(Gs[t] - Gsv);
            Lf[t * 68 + s] = s < t ? Bs[t] * kk_[r] * dec : 0.f; QKM[(size_t)u * 4096 + t * 64 + s] = f2bf(s <= t ? qk_[r] * dec : 0.f); } }
    if (w < 6) { const int ti = w < 3 ? 0 : (w < 5 ? 1 : 2), si = w < 3 ? w + 1 : (w < 5 ? w - 1 : 3);
#pragma unroll
        for (int r = 0; r < 4; ++r) QKM[(size_t)u * 4096 + (16 * ti + 4 * g + r) * 64 + 16 * si + i] = 0; }
    __syncthreads();
    if (wid == 0) {
        float T[64];
#pragma unroll
        for (int t = 0; t < 64; ++t) { float a0 = (lane == t) ? 1.f : 0.f, a1 = 0.f, a2 = 0.f, a3 = 0.f;
#pragma unroll
            for (int s4 = 0; s4 < t; s4 += 4) { const f32x4 l = *(const LAS f32x4*)(Lf + t * 68 + s4);
                a0 -= l[0] * T[s4]; if (s4 + 1 < t) a1 -= l[1] * T[s4 + 1]; if (s4 + 2 < t) a2 -= l[2] * T[s4 + 2]; if (s4 + 3 < t) a3 -= l[3] * T[s4 + 3]; }
            T[t] = (a0 + a1) + (a2 + a3); Ts[t * 72 + lane] = f2bf(T[t]); }
    }
    __syncthreads();
#pragma unroll
    for (int tt = 0; tt < 4; ++tt) { f32x4 aW = {0.f, 0.f, 0.f, 0.f}, aU = aW;
#pragma unroll
        for (int ks = 0; ks < 2; ++ks) { const bf16x8 kb = *(const LAS bf16x8*)(KbT + (16 * w + i) * 72 + 32 * ks + 8 * g), tf = *(const LAS bf16x8*)(Ts + (16 * tt + i) * 72 + 32 * ks + 8 * g),
                                                      vb = *(const LAS bf16x8*)(VbT + (16 * w + i) * 72 + 32 * ks + 8 * g);
            aW = mfma16(kb, tf, aW); aU = mfma16(tf, vb, aU); }
        u32x2 ww; ww.x = pk2(aW[0], aW[1]); ww.y = pk2(aW[2], aW[3]); *(u32x2*)(QKV + (r0 + 16 * tt + i) * 3072 + 1024 + h * 128 + 16 * w + 4 * g) = ww;
        u32x2 uu; uu.x = pk2(aU[0], aU[1]); uu.y = pk2(aU[2], aU[3]); *(u32x2*)(UT + (size_t)u * 8192 + (16 * w + i) * 64 + 16 * tt + 4 * g) = uu; }
    if (tid == 0) GLAST[u] = __expf(Glast);
    __syncthreads();
}
DEV void gdn_seq(const Ctx& c, int bh, LAS char* L, int tid, int wid, int lane) {
    const int b = bh >> 3, h = bh & 7, g = lane >> 4, i = lane & 15, w = wid; const int u0 = bh * 128; const long rbase = (long)b * SEQ;
    const bf16_t* QKV = (const bf16_t*)(c.BIG() + B_QKV); const bf16_t* KT = (const bf16_t*)(c.BIG() + B_KT); const bf16_t* UT = (const bf16_t*)(c.BIG() + B_UT); const bf16_t* QKM = (const bf16_t*)(c.BIG() + B_QKM);
    const bf16_t* GG = (const bf16_t*)(c.BIG() + B_GG); const float* GLAST = (const float*)(c.BIG() + B_GLAST);
    constexpr int BUF = 62464, O_W = 0, O_Q = 17408, O_QK = 34816, O_KT = 44032;
    LAS float* red = (LAS float*)(L + 2 * BUF);
    f32x4 S[8];
#pragma unroll
    for (int mt = 0; mt < 8; ++mt) S[mt] = (f32x4){0.f, 0.f, 0.f, 0.f};
    u32x4 st[7];
#define GDN_LOAD(cix) do { const long rr = rbase + (cix) * 64; const size_t uu_ = (size_t)(u0 + (cix)); \
        _Pragma("unroll") for (int it = 0; it < 2; ++it) { const int idx = it * NTHR + tid, t = idx >> 4, cc = idx & 15; \
            st[it] = *(const u32x4*)(QKV + (rr + t) * 3072 + 1024 + h * 128 + cc * 8); st[2 + it] = *(const u32x4*)(QKV + (rr + t) * 3072 + h * 128 + cc * 8); \
            st[5 + it] = *(const u32x4*)(KT + uu_ * 8192 + (idx >> 3) * 64 + (idx & 7) * 8); } \
        st[4] = *(const u32x4*)(QKM + uu_ * 4096 + (tid >> 3) * 64 + (tid & 7) * 8); } while (0)
#define GDN_STORE(bufp) do { \
        _Pragma("unroll") for (int it = 0; it < 2; ++it) { const int idx = it * NTHR + tid, t = idx >> 4, cc = idx & 15; \
            *(LAS u32x4*)((bufp) + O_W + (t * 136 + cc * 8) * 2) = st[it]; *(LAS u32x4*)((bufp) + O_Q + (t * 136 + cc * 8) * 2) = st[2 + it]; \
            *(LAS u32x4*)((bufp) + O_KT + ((idx >> 3) * 72 + (idx & 7) * 8) * 2) = st[5 + it]; } \
        *(LAS u32x4*)((bufp) + O_QK + ((tid >> 3) * 72 + (tid & 7) * 8) * 2) = st[4]; } while (0)
    GDN_LOAD(0); GDN_STORE(L);
    __syncthreads();
#pragma unroll 1
    for (int cix = 0; cix < 128; ++cix) {
        LAS char* cur = L + (cix & 1) * BUF; LAS char* nxt = L + ((cix + 1) & 1) * BUF;
        if (cix + 1 < 128) GDN_LOAD(cix + 1);
        const size_t uu = (size_t)(u0 + cix); u32x2 uv[4];
#pragma unroll
        for (int tt = 0; tt < 4; ++tt) uv[tt] = *(const u32x2*)(UT + uu * 8192 + (16 * w + i) * 64 + 16 * tt + 4 * g);
        const float gl = GLAST[uu];
        const LAS bf16_t* Ws = (const LAS bf16_t*)(cur + O_W); const LAS bf16_t* Qs = (const LAS bf16_t*)(cur + O_Q); const LAS bf16_t* QKs = (const LAS bf16_t*)(cur + O_QK); const LAS bf16_t* KTs = (const LAS bf16_t*)(cur + O_KT);
        bf16x8 sf[4];
#pragma unroll
        for (int kk = 0; kk < 4; ++kk) sf[kk] = mk8f(S[2 * kk], S[2 * kk + 1]);
        f32x4 dl[4];
#pragma unroll
        for (int tt = 0; tt < 4; ++tt) { f32x4 ws = {0.f, 0.f, 0.f, 0.f};
#pragma unroll
            for (int kk = 0; kk < 4; ++kk) { const LAS bf16_t* p = Ws + (16 * tt + i) * 136 + 32 * kk + 4 * g; ws = mfma16(mk8(*(const LAS u32x2*)p, *(const LAS u32x2*)(p + 16)), sf[kk], ws); }
            dl[tt][0] = lo16(uv[tt].x) - ws[0]; dl[tt][1] = hi16(uv[tt].x) - ws[1]; dl[tt][2] = lo16(uv[tt].y) - ws[2]; dl[tt][3] = hi16(uv[tt].y) - ws[3]; }
        const bf16x8 df0 = mk8f(dl[0], dl[1]), df1 = mk8f(dl[2], dl[3]);
        f32x4 oT[4];
#pragma unroll
        for (int tt = 0; tt < 4; ++tt) { f32x4 o = {0.f, 0.f, 0.f, 0.f};
#pragma unroll
            for (int kk = 0; kk < 4; ++kk) { const LAS bf16_t* p = Qs + (16 * tt + i) * 136 + 32 * kk + 4 * g; o = mfma16(sf[kk], mk8(*(const LAS u32x2*)p, *(const LAS u32x2*)(p + 16)), o); }
            { const LAS bf16_t* p = QKs + (16 * tt + i) * 72 + 4 * g; o = mfma16(df0, mk8(*(const LAS u32x2*)p, *(const LAS u32x2*)(p + 16)), o); o = mfma16(df1, mk8(*(const LAS u32x2*)(p + 32), *(const LAS u32x2*)(p + 48)), o); }
            oT[tt] = o; }
#pragma unroll
        for (int mt = 0; mt < 8; ++mt) { const LAS bf16_t* p = KTs + (16 * mt + i) * 72 + 4 * g; f32x4 s = S[mt] * gl;
            s = mfma16(mk8(*(const LAS u32x2*)p, *(const LAS u32x2*)(p + 16)), df0, s); s = mfma16(mk8(*(const LAS u32x2*)(p + 32), *(const LAS u32x2*)(p + 48)), df1, s); S[mt] = s; }
        float ss[4];
#pragma unroll
        for (int tt = 0; tt < 4; ++tt) { float v = oT[tt][0] * oT[tt][0] + oT[tt][1] * oT[tt][1] + oT[tt][2] * oT[tt][2] + oT[tt][3] * oT[tt][3]; v += __shfl_xor(v, 16); v += __shfl_xor(v, 32); ss[tt] = v; }
        if (g == 0) {
#pragma unroll
            for (int tt = 0; tt < 4; ++tt) red[w * 64 + 16 * tt + i] = ss[tt]; }
        __syncthreads();
        const int dvb = 16 * w + 4 * g; const f32x4 ng = *(const f32x4*)(c.in(I_GNG) + dvb);
#pragma unroll
        for (int tt = 0; tt < 4; ++tt) { float tot = 0.f;
#pragma unroll
            for (int ww = 0; ww < 8; ++ww) tot += red[ww * 64 + 16 * tt + i];
            const float rs = 1.f / sqrtf(tot * (1.f / 128.f) + 1e-6f); const long row = rbase + cix * 64 + 16 * tt + i; const u32x2 gt = *(const u32x2*)(GG + row * 1024 + h * 128 + dvb);
            u32x2 wv; wv.x = pk2(oT[tt][0] * rs * ng[0] * lo16(gt.x), oT[tt][1] * rs * ng[1] * hi16(gt.x)); wv.y = pk2(oT[tt][2] * rs * ng[2] * lo16(gt.y), oT[tt][3] * rs * ng[3] * hi16(gt.y));
            *(u32x2*)(c.AO() + row * D + h * 128 + dvb) = wv; }
        if (cix + 1 < 128) GDN_STORE(nxt);
        __syncthreads();
    }
#undef GDN_LOAD
#undef GDN_STORE
    { LAS float* Sl = (LAS float*)L;
#pragma unroll
      for (int mt = 0; mt < 8; ++mt)
#pragma unroll
          for (int r = 0; r < 4; ++r) Sl[(16 * mt + 4 * g + r) * 128 + 16 * w + i] = S[mt][r];
      __syncthreads();
      float* dst = c.out() + OFF_PG + (size_t)bh * 16384;
#pragma unroll 2
      for (int it = 0; it < 8; ++it) { const int idx = it * NTHR + tid; *(f32x4*)(dst + idx * 4) = *(const LAS f32x4*)(Sl + idx * 4); } }
}
DEV void samp_gdn_unit(const Ctx& c, int unit, LAS char* L, int tid, int wid, int lane) {
    const int bi = unit >> 3, h = unit & 7; const long row = NP + bi;
    const bf16_t* QKV = (const bf16_t*)(c.BIG() + B_QKV); const bf16_t* GG = (const bf16_t*)(c.BIG() + B_GG); const float* LA = (const float*)(c.BIG() + B_LA); const float* BETA = (const float*)(c.BIG() + B_BETA);
    LAS float* y = (LAS float*)L; LAS float* red = y + 384; LAS float* red2 = red + 512; LAS float* misc = red2 + 512;
    if (tid < 384) { const int col = (tid >> 7) * 1024 + h * 128 + (tid & 127); const float* hs = c.in(I_SC) + (size_t)bi * 3 * 3072 + col; const float* cw = c.in(I_CONVW) + col;
        const float h0 = hs[0], h1 = hs[3072], h2 = hs[6144], x3 = bf2f(QKV[row * 3072 + col]);
        y[tid] = silu(cw[0] * h0 + cw[3072] * h1 + cw[6144] * h2 + cw[9216] * x3);
        float* so = c.out() + OFF_SC + (size_t)bi * 3 * 3072 + col; so[0] = h1; so[3072] = h2; }
    __syncthreads();
    if (wid < 4) { const float a = y[tid]; const float s = wave_sum(a * a); if (lane == 0) misc[wid] = s; }
    else if (wid == 4) { const float s = wave_sum(y[lane] * y[128 + lane] + y[64 + lane] * y[192 + lane]); if (lane == 0) misc[4] = s; }
    __syncthreads();
    const float qn = (1.f / sqrtf(misc[0] + misc[1] + 1e-6f)) * 0.08838834764831845f, kn = 1.f / sqrtf(misc[2] + misc[3] + 1e-6f), qk = misc[4] * qn * kn;
    const float a = __expf(LA[row * 8 + h]), be = BETA[row * 8 + h];
    const int dv = tid & 127, kg = tid >> 7;
    const float* S0 = c.in(I_SG) + ((size_t)(bi * 8 + h) * 128) * 128; float* Sn = c.out() + OFF_SG + ((size_t)(bi * 8 + h) * 128) * 128;
    float pk_ = 0.f, pq_ = 0.f;
#pragma unroll 8
    for (int kk = 0; kk < 32; ++kk) { const int kd = kg * 32 + kk; const float sv = S0[kd * 128 + dv]; pk_ += y[128 + kd] * sv; pq_ += y[kd] * sv; }
    red[kg * 128 + dv] = pk_ * kn; red2[kg * 128 + dv] = pq_ * qn;
    __syncthreads();
    const float kS = red[dv] + red[128 + dv] + red[256 + dv] + red[384 + dv], qS = red2[dv] + red2[128 + dv] + red2[256 + dv] + red2[384 + dv];
    const float delta = be * (y[256 + dv] - a * kS), o = a * qS + qk * delta;
#pragma unroll 8
    for (int kk = 0; kk < 32; ++kk) { const int kd = kg * 32 + kk; Sn[kd * 128 + dv] = a * S0[kd * 128 + dv] + y[128 + kd] * kn * delta; }
    __syncthreads();
    if (tid < 128) { const float s2 = wave_sum(o * o); if (lane == 0) misc[8 + wid] = s2; }
    __syncthreads();
    if (tid < 128) { const float rs = 1.f / sqrtf((misc[8] + misc[9]) * (1.f / 128.f) + 1e-6f);
        c.AO()[row * D + h * 128 + dv] = f2bf(o * rs * c.in(I_GNG)[dv] * bf2f(GG[row * 1024 + h * 128 + dv])); }
}
constexpr int LDS_BYTES = 147456;
constexpr int NPH = 26;

template <class Epi> DEV void run_gemm(LAS char* L, const bf16_t* A, const bf16_t* Bt, int M, int N, int K, const Epi& E, int tid, int blk, int G) {
    pg8::Gemm g{A, Bt, M, N, K}; pg8::StaticOrder S; S.init(M, N, G, blk);
    pg8::gemm_phase<Epi, pg8::StaticOrder, true, true>((PG8_LAS unsigned char*)L, g, S, E, tid);
}

#ifndef MK_PHMASK
#define MK_PHMASK 0xffffffffu
#endif
#define EN(k) (((MK_PHMASK) >> (k)) & 1u)
__global__ void __launch_bounds__(NTHR, 2) fwd_kernel(const Args a) {
    extern __shared__ __attribute__((aligned(16))) unsigned char lds_raw[];
    LAS char* L = (LAS char*)lds_raw;
    cooperative_groups::grid_group grid = cooperative_groups::this_grid();
    const int lo = a.ph_lo, hi = a.ph_hi;
#define PH_BEGIN(k) if (EN(k) && lo <= (k) && (k) < hi) { \
        int tid = threadIdx.x; asm volatile("" : "+v"(tid)); int blk = blockIdx.x; asm volatile("" : "+s"(blk)); int G = gridDim.x; asm volatile("" : "+s"(G)); \
        unsigned char* wsp = a.ws; asm volatile("" : "+s"(wsp)); float* outp = a.out; asm volatile("" : "+s"(outp)); \
        const int lane = tid & 63, wid = __builtin_amdgcn_readfirstlane(tid >> 6), gw = blk * 8 + wid, NGW = G * 8; \
        const Ctx c{a, wsp, outp}; bf16_t* H = (bf16_t*)(c.BIG() + B_H); (void)lane; (void)gw; (void)NGW; (void)H;
#define PH_END(k) } if (lo <= (k) && (k) + 1 < hi) { if (a.coop) grid.sync(); }
#define PH_UP(k, l, j) PH_BEGIN(k) { EpiSwiGLU E{H}; run_gemm(L, c.AO(), c.WUP() + (size_t)((l) * 2 + (j)) * 2 * DFF * D, MT, 2 * DFF, D, E, tid, blk, G); } PH_END(k)
#define PH_DOWN(k, l, j, first) PH_BEGIN(k) { EpiResid E{(first) ? c.in(I_XP) : c.X(), (first) ? c.in(I_XS) : c.X() + (size_t)NP * D, c.X(), c.MODS() + ((l) * 9 + ((j) == 0 ? 2 : 8)) * 1024, 0.5f}; \
        run_gemm(L, H, c.WDN() + (size_t)((l) * 2 + (j)) * D * DFF, MT, D, DFF, E, tid, blk, G); } PH_END(k)
#define PH_LN(k, lni, nmod) PH_BEGIN(k) phase_ln(c, lni, nmod, gw, NGW, lane); PH_END(k)
#define PH_OUT(k, l, Wt) PH_BEGIN(k) { EpiResid E{c.X(), c.X() + (size_t)NP * D, c.X(), c.MODS() + ((l) * 9 + 5) * 1024, 1.0f}; run_gemm(L, c.AO(), Wt, MT, D, D, E, tid, blk, G); } PH_END(k)

    PH_BEGIN(0) phase_prologue(c, L, gw, NGW, wid, lane); PH_END(0)
    PH_BEGIN(1) { EpiMods E{c.MODS(), c.in(I_ADAB)}; run_gemm(L, (const bf16_t*)(c.BIG() + B_ACS), (const bf16_t*)(c.BIG() + B_ADAT), 256, NMODC, D, E, tid, blk, G); } PH_END(1)
    PH_BEGIN(2) phase_mod0(c, gw, NGW, lane); PH_END(2)
    PH_UP(3, 0, 0)
    PH_DOWN(4, 0, 0, true)
    PH_LN(5, 0, 0 * 9 + 3)
    PH_BEGIN(6) { EpiEvenIn E{(bf16_t*)(c.BIG() + B_QA), (bf16_t*)(c.BIG() + B_KA), (bf16_t*)(c.BIG() + B_VA), (bf16_t*)(c.BIG() + B_QB), (bf16_t*)(c.BIG() + B_KB), (bf16_t*)(c.BIG() + B_VB), (bf16_t*)(c.BIG() + B_GB),
                              (float*)(c.BIG() + B_LOGF), c.in(I_LBL), c.out()};
        run_gemm(L, c.AO(), c.WEIN(), MT, EIN, D, E, tid, blk, G); } PH_END(6)
    PH_BEGIN(7)
#pragma unroll 1
        for (int u = blk; u < 1152; u += G) {
            if (u < 256) { if (EN(26)) swa_unit(c, u, L, tid, wid, lane); } else if (u < 512) { if (EN(27)) hgrn_unit(c, u - 256, false, L, tid, wid, lane); }
            else if (u < 640) { if (EN(28)) samp_swa_unit(c, u - 512, L, tid, wid, lane); } else { if (EN(29)) samp_hgrn_unit(c, u - 640, L, tid, wid, lane); }
            __syncthreads(); }
    PH_END(7)
    PH_BEGIN(8)
#pragma unroll 1
        for (int u = blk; u < 256; u += G) { hgrn_unit(c, u, true, L, tid, wid, lane); __syncthreads(); }
    PH_END(8)
    PH_OUT(9, 0, c.WEOUT())
    PH_LN(10, 1, 0 * 9 + 6)
    PH_UP(11, 0, 1)
    PH_DOWN(12, 0, 1, false)
    PH_LN(13, 2, 1 * 9 + 0)
    PH_UP(14, 1, 0)
    PH_DOWN(15, 1, 0, false)
    PH_LN(16, 3, 1 * 9 + 3)
    PH_BEGIN(17) { EpiOddIn E{(bf16_t*)(c.BIG() + B_QKV), (bf16_t*)(c.BIG() + B_GG), (bf16_t*)(c.BIG() + B_HALO), (float*)(c.BIG() + B_LA), (float*)(c.BIG() + B_BETA), c.in(I_ALOG), c.in(I_DTB), c.out()};
        run_gemm(L, c.AO(), c.WOIN(), MT, OINP, D, E, tid, blk, G); } PH_END(17)
    PH_BEGIN(18)
#pragma unroll 1
        for (int u = blk; u < 256; u += G) conv_unit(c, u, tid, lane);
    PH_END(18)
    PH_BEGIN(19)
#pragma unroll 1
        for (int u = blk; u < 2048; u += G) prep_unit(c, u, L, tid, wid, lane);
    PH_END(19)
    PH_BEGIN(20)
        if (blk < 16) { if (EN(30)) gdn_seq(c, blk, L, tid, wid, lane); }
        else {
#pragma unroll 1
            for (int u = blk - 16; u < 1024; u += G - 16) { if (EN(31)) samp_gdn_unit(c, u, L, tid, wid, lane); __syncthreads(); } }
    PH_END(20)
    PH_OUT(21, 1, c.WOOUT())
    PH_LN(22, 4, 1 * 9 + 6)
    PH_UP(23, 1, 1)
    PH_DOWN(24, 1, 1, false)
    PH_LN(25, 5, -1)
}
}

extern "C" void kernel_launch(void* const* d_in, const int* in_sizes, int n_in, void* d_out, int out_size, void* d_ws, size_t ws_size, hipStream_t stream) {
    using namespace mk;
    static int inited = 0;
    if (!inited) {
        if (n_in != 26 || (size_t)out_size != OUT_TOTAL || ws_size < WS_END) { fprintf(stderr, "kernel_launch: unexpected shapes n_in %d out %d ws %zu (need %zu)\n", n_in, out_size, ws_size, (size_t)WS_END); inited = -1; return; }
        if (hipFuncSetAttribute((const void*)fwd_kernel, hipFuncAttributeMaxDynamicSharedMemorySize, LDS_BYTES) != hipSuccess) { fprintf(stderr, "kernel_launch: hipFuncSetAttribute failed\n"); inited = -1; return; }
        inited = 1;
    }
    if (inited < 0) return;
    Args a{};
    for (int i = 0; i < 26; ++i) a.in[i] = (const float*)d_in[i];
    a.out = (float*)d_out; a.ws = (unsigned char*)d_ws;
#ifndef MK_ONE_LAUNCH
    a.coop = 0;
#ifndef MK_PH_HI
#define MK_PH_HI NPH
#endif
    for (int ph = 0; ph < MK_PH_HI; ++ph) { a.ph_lo = ph; a.ph_hi = ph + 1; hipLaunchKernelGGL(fwd_kernel, dim3(256), dim3(NTHR), LDS_BYTES, stream, a); }
#else
    a.coop = 1; a.ph_lo = 0; a.ph_hi = NPH;
    void* args[] = {&a};
    hipError_t e = hipLaunchCooperativeKernel((const void*)fwd_kernel, dim3(256), dim3(NTHR), args, LDS_BYTES, stream);
    if (e != hipSuccess) fprintf(stderr, "cooperative launch failed: %s\n", hipGetErrorString(e));
#endif
}
```
